# Optimizing an MI355X kernel written in HIP

```python
import jax, jax.numpy as jnp
from jax import lax
import numpy as np

D_MODEL = 2048
BATCH = 4
SEQ = 4096
DEPTH = 1

CHUNK = 64
MIX_WIDTH = D_MODEL
HG_HEADS = 8
HG_HEAD_DIM = 128
HG_WIDTH = HG_HEADS * HG_HEAD_DIM
ATT_HEADS = 8
ATT_HEAD_DIM = 128
ATT_WIDTH = ATT_HEADS * ATT_HEAD_DIM
LEFT_CHUNKS = 8
BAND = (LEFT_CHUNKS + 1) * CHUNK
REL_CLIP = 128
D_FF = 5632
CONV_WIDTH = 3
PLE_DIM = 256
EPS = 1e-6
IN_SPLITS = (HG_WIDTH, HG_WIDTH, HG_WIDTH, HG_WIDTH, ATT_WIDTH, ATT_WIDTH, ATT_WIDTH)
IN_COLS = sum(IN_SPLITS)

kernel_name = "hybrid_hgrn2_chunkattn_convffn_ple"


def rmsnorm(x, g):
    xf = x.astype(jnp.float32)
    y = xf * lax.rsqrt(jnp.mean(xf * xf, axis=-1, keepdims=True) + EPS)
    return (y * g.astype(jnp.float32)).astype(x.dtype)


def hgrn2_mixer(q, f_pre, i_in, g, lb, norm_g):
    B, S, _ = q.shape
    nc = S // CHUNK
    lb = lb.astype(jnp.float32)
    sig = jax.nn.sigmoid(f_pre.astype(jnp.float32))
    f = lb + (1.0 - lb) * sig
    log_f = jnp.log(f)
    k = (1.0 - lb) * jax.nn.sigmoid(-f_pre.astype(jnp.float32))
    qf = jax.nn.silu(q.astype(jnp.float32))
    vf = i_in.astype(jnp.float32)

    def heads(t):
        return t.reshape(B, nc, CHUNK, HG_HEADS, HG_HEAD_DIM).transpose(1, 0, 3, 2, 4)

    causal = jnp.tril(jnp.ones((CHUNK, CHUNK), dtype=bool))

    def step(state, inp):
        qc, kc, vc, lfc = inp
        b = jnp.cumsum(lfc, axis=2)
        diff = b[:, :, :, None, :] - b[:, :, None, :, :]
        decay = jnp.exp(jnp.where(causal[None, None, :, :, None], diff, -jnp.inf))
        scores = jnp.einsum('bhtd,bhsd,bhtsd->bhts', qc, kc, decay)
        o_intra = jnp.einsum('bhts,bhsv->bhtv', scores, vc)
        o_inter = jnp.einsum('bhtd,bhdv->bhtv', qc * jnp.exp(b), state)
        b_last = b[:, :, -1:, :]
        new_state = (jnp.exp(b_last[:, :, 0, :])[..., None] * state
                     + jnp.einsum('bhsd,bhsv->bhdv', kc * jnp.exp(b_last - b), vc))
        return new_state, o_intra + o_inter

    s0 = jnp.zeros((B, HG_HEADS, HG_HEAD_DIM, HG_HEAD_DIM), jnp.float32)
    _, o = lax.scan(step, s0, (heads(qf), heads(k), heads(vf), heads(log_f)))
    o = o.transpose(1, 0, 3, 2, 4).reshape(B, S, HG_HEADS, HG_HEAD_DIM)
    o = rmsnorm(o, norm_g)
    gate = jax.nn.silu(g.astype(jnp.float32)).reshape(B, S, HG_HEADS, HG_HEAD_DIM)
    return (o * gate).reshape(B, S, HG_WIDTH).astype(q.dtype)


def chunk_attention(q, k, v, rel_bias):
    B, S, _ = q.shape
    nc = S // CHUNK
    pad = LEFT_CHUNKS * CHUNK

    def heads(t):
        return t.reshape(B, S, ATT_HEADS, ATT_HEAD_DIM).transpose(0, 2, 1, 3)

    qh = heads(q) * (ATT_HEAD_DIM ** -0.5)
    kp = jnp.pad(heads(k), ((0, 0), (0, 0), (pad, 0), (0, 0)))
    vp = jnp.pad(heads(v), ((0, 0), (0, 0), (pad, 0), (0, 0)))
    t_off = jnp.arange(CHUNK)[:, None]
    j_off = jnp.arange(BAND)[None, :]
    rel = t_off + pad - j_off
    bias = rel_bias.astype(jnp.float32)[:, jnp.clip(rel, -REL_CLIP, REL_CLIP) + REL_CLIP]
    band_idx = jnp.arange(BAND)

    def one_chunk(c):
        start = c * CHUNK
        qc = lax.dynamic_slice_in_dim(qh, start, CHUNK, axis=2)
        kc = lax.dynamic_slice_in_dim(kp, start, BAND, axis=2)
        vc = lax.dynamic_slice_in_dim(vp, start, BAND, axis=2)
        s = jnp.einsum('bhtd,bhsd->bhts', qc, kc).astype(jnp.float32) + bias[None]
        valid = (start - pad + band_idx) >= 0
        s = jnp.where(valid[None, None, None, :], s, jnp.finfo(jnp.float32).min)
        pr = jax.nn.softmax(s, axis=-1)
        return jnp.einsum('bhts,bhsd->bhtd', pr.astype(vc.dtype), vc)

    out = lax.map(one_chunk, jnp.arange(nc))
    return out.transpose(1, 0, 3, 2, 4).reshape(B, S, ATT_WIDTH)


def conv_ffn(h, w_up, conv_w, conv_b, w_down):
    S = h.shape[1]
    u = h @ w_up
    up = jnp.pad(u, ((0, 0), (CONV_WIDTH - 1, 0), (0, 0)))
    uc = conv_b + sum(conv_w[j] * up[:, j:j + S] for j in range(CONV_WIDTH))
    gate, val = uc[..., :D_FF], uc[..., D_FF:]
    return (jax.nn.silu(gate) * val) @ w_down


def setup_inputs(seed: int = 0) -> dict:
    key = jax.random.key(seed)
    ks = jax.random.split(key, 20)
    f32 = jnp.float32
    nrm = lambda k, shape, s: jax.random.normal(k, shape, f32) * s
    return {
        "x": nrm(ks[0], (BATCH, SEQ, D_MODEL), 1.0),
        "p": nrm(ks[1], (DEPTH, BATCH, SEQ, PLE_DIM), 1.0),
        "norm_mix": 1.0 + nrm(ks[2], (DEPTH, D_MODEL), 0.02),
        "w_in": nrm(ks[3], (DEPTH, D_MODEL, IN_COLS), D_MODEL ** -0.5),
        "lb_logits": nrm(ks[4], (DEPTH + 1, HG_WIDTH), 0.5),
        "hg_norm": 1.0 + nrm(ks[5], (DEPTH, HG_HEAD_DIM), 0.02),
        "rel_bias": nrm(ks[6], (DEPTH, ATT_HEADS, 2 * REL_CLIP + 1), 0.5),
        "w_out": nrm(ks[7], (DEPTH, MIX_WIDTH, D_MODEL), MIX_WIDTH ** -0.5),
        "norm_ffn": 1.0 + nrm(ks[8], (DEPTH, D_MODEL), 0.02),
        "w_up": nrm(ks[9], (DEPTH, D_MODEL, 2 * D_FF), D_MODEL ** -0.5),
        "conv_w": nrm(ks[10], (DEPTH, CONV_WIDTH, 2 * D_FF), CONV_WIDTH ** -0.5),
        "conv_b": nrm(ks[11], (DEPTH, 2 * D_FF), 0.02),
        "w_down": nrm(ks[12], (DEPTH, D_FF, D_MODEL), D_FF ** -0.5),
        "norm_ple": 1.0 + nrm(ks[13], (DEPTH, D_MODEL), 0.02),
        "w_ple_gate": nrm(ks[14], (DEPTH, D_MODEL, D_MODEL), D_MODEL ** -0.5),
        "w_ple_proj": nrm(ks[15], (DEPTH, PLE_DIM, D_MODEL), PLE_DIM ** -0.5),
        "final_norm": 1.0 + nrm(ks[16], (D_MODEL,), 0.02),
    }


def reference(x, p, norm_mix, w_in, lb_logits, hg_norm, rel_bias, w_out, norm_ffn,
              w_up, conv_w, conv_b, w_down, norm_ple, w_ple_gate, w_ple_proj, final_norm):
    lb_all = jnp.cumsum(jax.nn.softmax(lb_logits.astype(jnp.float32), axis=0), axis=0)[:DEPTH]
    split_idx = [int(v) for v in np.cumsum(IN_SPLITS)[:-1]]
    h = x
    for i in range(DEPTH):
        a = rmsnorm(h, norm_mix[i])
        proj = a @ w_in[i]
        hq, hf, hi, hg, aq, ak, av = jnp.split(proj, split_idx, axis=-1)
        y_hg = hgrn2_mixer(hq, hf, hi, hg, lb_all[i], hg_norm[i])
        y_att = chunk_attention(aq, ak, av, rel_bias[i])
        h = h + jnp.concatenate([y_hg, y_att], axis=-1) @ w_out[i]
        h = h + conv_ffn(rmsnorm(h, norm_ffn[i]), w_up[i], conv_w[i], conv_b[i], w_down[i])
        gate = jax.nn.sigmoid(rmsnorm(h, norm_ple[i]) @ w_ple_gate[i])
        h = h + gate * (p[i] @ w_ple_proj[i])
    return rmsnorm(h, final_norm)
```

```cpp
#include <hip/hip_runtime.h>
#include <hip/hip_cooperative_groups.h>
#include <cstdio>
namespace cg = cooperative_groups;

#define LAS __attribute__((address_space(3)))
typedef unsigned short bf16_t;
typedef short bf16x8 __attribute__((ext_vector_type(8)));
typedef short s16x4 __attribute__((ext_vector_type(4)));
typedef float f32x4 __attribute__((ext_vector_type(4)));
typedef float f32x2 __attribute__((ext_vector_type(2)));
typedef unsigned u32x4 __attribute__((ext_vector_type(4)));
typedef unsigned u32x2 __attribute__((ext_vector_type(2)));

constexpr int MTOK = 16384, DM = 2048, INC = 7168, FF = 5632, FF2 = 11264, PLE = 256, SEQ = 4096;
constexpr int LDS_BYTES = 149 * 1024;
constexpr float EPS = 1e-6f;
constexpr float LOG2E = 1.4426950408889634f;

constexpr size_t MiB = 1048576;
constexpr size_t WS_WIN = 0, WS_WOUT = 28 * MiB, WS_WUP = 36 * MiB, WS_WDOWN = 80 * MiB, WS_WGATE = 102 * MiB, WS_WPROJ = 110 * MiB;
constexpr size_t WS_PROJ = 111 * MiB;
constexpr size_t WS_XA = 335 * MiB;
constexpr size_t WS_YCAT = 335 * MiB;
constexpr size_t WS_SST = 399 * MiB;
constexpr size_t WS_DDEC = 463 * MiB;
constexpr size_t WS_SSQ1 = 464 * MiB, WS_SSQ2 = 466 * MiB, WS_SSQ3 = 468 * MiB;
constexpr size_t WS_PB = 470 * MiB;
constexpr size_t WS_H1B = 111 * MiB;
constexpr size_t WS_PP = 175 * MiB;
constexpr size_t WS_ACT = 239 * MiB;
constexpr size_t WS_UEDGE = 415 * MiB;
constexpr size_t WS_BAR = 478 * MiB;
constexpr size_t WS_END = 479 * MiB;

struct Params { const float* in[17]; float* out; unsigned char* ws; };

__device__ __forceinline__ unsigned cvt_pk_bf16(float lo, float hi) { unsigned r; asm volatile("v_cvt_pk_bf16_f32 %0, %1, %2" : "=v"(r) : "v"(lo), "v"(hi)); return r; }
__device__ __forceinline__ float bf2f(unsigned short b) { return __uint_as_float(((unsigned)b) << 16); }
__device__ __forceinline__ float bflo(unsigned w) { return __uint_as_float(w << 16); }
__device__ __forceinline__ float bfhi(unsigned w) { return __uint_as_float(w & 0xffff0000u); }
__device__ __forceinline__ float sigmoidf_(float x) { return __builtin_amdgcn_rcpf(1.0f + __expf(-x)); }
__device__ __forceinline__ size_t proj_off(int row, int col) {
    const int rl = row & 255, cl = col & 255; const size_t tb = (size_t)((row >> 8) * 28 + (col >> 8)) << 16;
    if (col < 2048) return tb + (size_t)((rl << 8) + cl);
    const int wv = ((rl >> 6) & 1) * 4 + ((cl >> 5) & 3), k = (((rl >> 7) & 1) * 4 + ((rl >> 4) & 3)) * 2 + ((cl >> 7) & 1), ln = ((cl >> 3) & 3) * 16 + (rl & 15);
    return tb + (size_t)((((wv * 16 + k) * 64 + ln) << 3) + (cl & 7));
}
__device__ __forceinline__ long proj_off_rm(int row, int col) { return ((long)((row >> 8) * 28 + (col >> 8)) << 16) + (long)(((row & 255) << 8) + (col & 255)); }
__device__ __forceinline__ long proj_off_fr(int row, int col) {
    const int rl = row & 255, cl = col & 255;
    const int wv = ((rl >> 6) & 1) * 4 + ((cl >> 5) & 3), k = (((rl >> 7) & 1) * 4 + ((rl >> 4) & 3)) * 2 + ((cl >> 7) & 1), ln = ((cl >> 3) & 3) * 16 + (rl & 15);
    return ((long)((row >> 8) * 28 + (col >> 8)) << 16) + (long)((((wv * 16 + k) * 64 + ln) << 3) + (cl & 7));
}
__device__ __forceinline__ unsigned off_b(unsigned row, unsigned ch) { return 256u * row + 16u * (ch ^ (((row & 3u) << 2) | ((row >> 2) & 3u))); }
__device__ __forceinline__ s16x4 tr_read(LAS unsigned char* p) { return __builtin_bit_cast(s16x4, __builtin_amdgcn_ds_read_tr16_b64_v4i16((LAS s16x4*)p)); }
__device__ __forceinline__ bf16x8 cat8(s16x4 a, s16x4 b) { return (bf16x8){a[0], a[1], a[2], a[3], b[0], b[1], b[2], b[3]}; }
__device__ __forceinline__ float dpp_ror1(float v) { return __int_as_float(__builtin_amdgcn_update_dpp(0, __float_as_int(v), 0x121, 0xf, 0xf, false)); }
__device__ __forceinline__ float dpp_shr1(float old, float v) { return __int_as_float(__builtin_amdgcn_update_dpp(__float_as_int(old), __float_as_int(v), 0x111, 0xf, 0xf, false)); }
__device__ __forceinline__ float dpp_shr2(float old, float v) { return __int_as_float(__builtin_amdgcn_update_dpp(__float_as_int(old), __float_as_int(v), 0x112, 0xf, 0xf, false)); }
__device__ __forceinline__ float dpp_ror2(float v) { return __int_as_float(__builtin_amdgcn_update_dpp(0, __float_as_int(v), 0x122, 0xf, 0xf, false)); }

__device__ __forceinline__ int lane_id_() { int l; asm volatile("v_mbcnt_lo_u32_b32 %0, -1, 0\n\tv_mbcnt_hi_u32_b32 %0, -1, %0" : "=v"(l)); return l; }
#define TID_X (WID * 64 + lane_id_())

#define XB_TMO      128
#define XB_XCNT(j)  (256  + 64 * (j))
#define XB_XSUB(j)  (1280 + 64 * (j))
#define XB_XGEN(j)  (2304 + 64 * (j))
#define XB_TOP      3328
#define XB_TOPGEN   3392
#define XCD_BAR_WORDS 3456
#define XB_SPIN_CAP (1u << 18)
__device__ __forceinline__ unsigned xb_ld(unsigned* p)              { return __hip_atomic_load(p, __ATOMIC_RELAXED, __HIP_MEMORY_SCOPE_AGENT); }
__device__ __forceinline__ unsigned xb_add(unsigned* p, unsigned v) { return __hip_atomic_fetch_add(p, v, __ATOMIC_RELAXED, __HIP_MEMORY_SCOPE_AGENT); }
__device__ __forceinline__ unsigned xb_xcc_id() { return (unsigned)__builtin_amdgcn_s_getreg((3 << 11) | 20) & 0xFu; }
#define XB_SPIN(cond, bar) do { unsigned _sp = 0; while (cond) { __builtin_amdgcn_s_sleep(1); \
    if ((++_sp & 255u) == 0u) { if (xb_ld(&(bar)[XB_TMO])) break; if (_sp > XB_SPIN_CAP) { atomicAdd(&(bar)[XB_TMO], 1u); break; } } } } while (0)
struct XcdBarrier { unsigned* bar; unsigned x; volatile LAS unsigned* st; };
__device__ __forceinline__ void xcd_barrier_complete(unsigned* bar, unsigned x, unsigned& nloc, unsigned& nx) {
    const unsigned G = gridDim.x;
    unsigned sum, cnt, mine, sp = 0u;
    for (;;) {
        sum = 0u; cnt = 0u; mine = 0u;
#pragma unroll
        for (unsigned j = 0; j < 16; ++j) { const unsigned c = xb_ld(&bar[XB_XCNT(j)]); sum += c; cnt += (c > 0u) ? 1u : 0u; mine = (j == x) ? c : mine; }
        if (sum == G) break;
        __builtin_amdgcn_s_sleep(1);
        if ((++sp & 255u) == 0u) { if (xb_ld(&bar[XB_TMO])) break; if (sp > XB_SPIN_CAP) { atomicAdd(&bar[XB_TMO], 1u); break; } }
    }
    nloc = mine > 0u ? mine : 1u; nx = cnt > 0u ? cnt : 1u;
}
__device__ __forceinline__ void xcd_barrier(const XcdBarrier& b, const int WID) {
    asm volatile("s_waitcnt vmcnt(0)" ::: "memory");
    __syncthreads();
    if (WID == 0 && lane_id_() == 0) {
        unsigned* bar = b.bar;
        __builtin_amdgcn_s_waitcnt(0);
        unsigned nloc = b.st[0], nx = b.st[1];
        if (nloc == 0u) { xcd_barrier_complete(bar, b.x, nloc, nx); b.st[0] = nloc; b.st[1] = nx; }
        const unsigned old = xb_add(&bar[XB_XSUB(b.x)], 1u);
        const unsigned gen = old / nloc;
        if (old + 1u == (gen + 1u) * nloc) {
            __builtin_amdgcn_fence(__ATOMIC_RELEASE, "agent");
            asm volatile("s_waitcnt vmcnt(0)" ::: "memory");
            const unsigned og = xb_add(&bar[XB_TOP], 1u);
            const unsigned tg = og / nx;
            if (og + 1u == (tg + 1u) * nx) xb_add(&bar[XB_TOPGEN], 1u);
            else XB_SPIN(xb_ld(&bar[XB_TOPGEN]) == tg, bar);
            __builtin_amdgcn_fence(__ATOMIC_ACQUIRE, "agent");
            xb_add(&bar[XB_XGEN(b.x)], 1u);
            asm volatile("s_waitcnt vmcnt(0)" ::: "memory");
        } else {
            XB_SPIN(xb_ld(&bar[XB_XGEN(b.x)]) == gen, bar);
            __builtin_amdgcn_fence(__ATOMIC_ACQUIRE, "agent");
            asm volatile("s_waitcnt vmcnt(0)" ::: "memory");
        }
    }
    __syncthreads();
}

namespace pg8 {
constexpr int BM = 256, BK = 64, HALF = 128, HTB = HALF * BK * 2, STAGE_BYTES = 8 * HTB, NXCD = 8, WGM = 8;
__device__ __forceinline__ int lds_byte(int r, int c) { const int st = (r >> 4) * 2 + (c >> 5), rr = r & 15, cc = c & 31, ob = rr * 64 + cc * 2; return st * 1024 + (ob ^ (((ob >> 9) & 1) << 5)); }
__device__ __forceinline__ void stage_rc(int b, int& R, int& C) { const int st = b / 1024, sb = b % 1024, swz = sb ^ (((sb >> 9) & 1) << 5); R = (st >> 1) * 16 + swz / 64; C = (st & 1) * 32 + (swz % 64) / 2; }
__device__ __forceinline__ int perm32(int rho) { const int n = rho >> 4, i = rho & 15; return 8 * (i >> 2) + 4 * n + (i & 3); }
struct Unit { int pm, pn; };
struct Gemm { const bf16_t* A; const bf16_t* Bt; int M, N, K; };
struct StaticOrder {
    int nM, nN, nwg, G, c;
    __device__ void init(int M, int N, int G_, int c_) { nM = M / BM; nN = N / BM; nwg = nM * nN; G = G_; c = c_; }
    __device__ bool next(int i, Unit& u) const {
        const long L = (long)i * G + c; if (L >= nwg) return false;
        int wgid = (int)L; { const int q = nwg / NXCD, r = nwg % NXCD, xcd = wgid % NXCD, off = wgid / NXCD; wgid = (xcd < r ? xcd * (q + 1) : r * (q + 1) + (xcd - r) * q) + off; }
        const int nig = WGM * nN, gid = wgid / nig, fm = gid * WGM, gsz = (nM - fm) < WGM ? (nM - fm) : WGM;
        u.pm = fm + ((wgid % nig) % gsz); u.pn = (wgid % nig) / gsz; return true;
    }
};

template <class Epi, bool KS0 = false>
__device__ __forceinline__ void gemm_phase(const int WID, LAS unsigned char* lds, const Gemm g, const StaticOrder& S, const Epi& E) {
    const int wid = WID, lane = lane_id_(), tid = wid * 64 + lane, wr = wid >> 2, wc = wid & 3, fr = lane & 15, fq = lane >> 4;
    const int K = g.K, nt = K / BK;
    unsigned voffA[2], voffB[2];
#pragma unroll
    for (int i = 0; i < 2; ++i) { int R, C; stage_rc(tid * 16 + i * 8192, R, C); const int Rb = Epi::PERM ? ((R & ~31) + perm32(R & 31)) : R;
        voffA[i] = (unsigned)(R * K + C) * 2u; voffB[i] = (unsigned)(Rb * K + C) * 2u; }
    const size_t kstep = KS0 ? (size_t)0 : (size_t)(BK * 2);
    const size_t hstep = (size_t)HALF * K * 2;
    const size_t tstep = 2 * hstep;
    const unsigned ldsw = (unsigned)wid * 1024u;
    const int aoff = lds_byte(wr * 64 + fr, fq * 8), boff = lds_byte(wc * 32 + fr, fq * 8);
#define PG8_SA(b, h) (((b) * 2 + (h)) * HTB)
#define PG8_SB(b, h) ((4 + (b) * 2 + (h)) * HTB)
#define PG8_STAGE(bufoff, gbase, voff) do { _Pragma("unroll") for (int _i = 0; _i < 2; ++_i) \
        __builtin_amdgcn_global_load_lds((const unsigned*)((const char*)(gbase) + (voff)[_i]), (LAS unsigned*)(lds + (bufoff) + ldsw + _i * 8192), 16, 0, 0); } while (0)
#define PG8_LDA(dst, b, h) do { _Pragma("unroll") for (int m = 0; m < 4; ++m) _Pragma("unroll") for (int k = 0; k < 2; ++k) dst[m][k] = *(const LAS bf16x8*)(lds + PG8_SA(b, h) + aoff + m * 2048 + k * 1024); } while (0)
#define PG8_LDB(dst, b, h) do { _Pragma("unroll") for (int n = 0; n < 2; ++n) _Pragma("unroll") for (int k = 0; k < 2; ++k) dst[n][k] = *(const LAS bf16x8*)(lds + PG8_SB(b, h) + boff + n * 2048 + k * 1024); } while (0)
#define PG8_MMA(ai, bj, At, Bt) do { __builtin_amdgcn_s_setprio(1); _Pragma("unroll") for (int m = 0; m < 4; ++m) _Pragma("unroll") for (int n = 0; n < 2; ++n) _Pragma("unroll") for (int k = 0; k < 2; ++k) \
        acc[ai][bj][m][n] = __builtin_amdgcn_mfma_f32_16x16x32_bf16(Bt[n][k], At[m][k], acc[ai][bj][m][n], 0, 0, 0); __builtin_amdgcn_s_setprio(0); } while (0)
#define PG8_WAIT_V(n) asm volatile("s_waitcnt vmcnt(" #n ")" ::: "memory")
#define PG8_WAIT_L(n) asm volatile("s_waitcnt lgkmcnt(" #n ")" ::: "memory")
#define PG8_BAR __builtin_amdgcn_s_barrier()
#define PG8_SCHED __builtin_amdgcn_sched_barrier(0)
    Unit cur, nxt; int ui = 0;
    if (!S.next(0, cur)) return;
    f32x4 acc[2][2][4][2];
#pragma unroll
    for (int a = 0; a < 2; ++a)
#pragma unroll
        for (int b = 0; b < 2; ++b)
#pragma unroll
            for (int m = 0; m < 4; ++m)
#pragma unroll
                for (int n = 0; n < 2; ++n) acc[a][b][m][n] = (f32x4){0.f, 0.f, 0.f, 0.f};
    bf16x8 At[4][2], B0[2][2], B1[2][2];
    const char* cA = (const char*)g.A + (size_t)cur.pm * tstep; const char* cB = (const char*)g.Bt + (size_t)cur.pn * tstep;
    PG8_STAGE(PG8_SB(0, 0), cB, voffB); PG8_STAGE(PG8_SA(0, 0), cA, voffA); PG8_STAGE(PG8_SB(0, 1), cB + hstep, voffB); PG8_STAGE(PG8_SA(0, 1), cA + hstep, voffA);
    if (wr == 1) PG8_BAR;
    PG8_WAIT_V(4); PG8_BAR;
    PG8_STAGE(PG8_SB(1, 0), cB + kstep, voffB); PG8_STAGE(PG8_SA(1, 0), cA + kstep, voffA); PG8_STAGE(PG8_SB(1, 1), cB + hstep + kstep, voffB);
    PG8_WAIT_V(6); PG8_BAR;
    for (;;) {
        const bool has_next = S.next(ui + 1, nxt);
        const char* nA = has_next ? (const char*)g.A + (size_t)nxt.pm * tstep : cA; const char* nB = has_next ? (const char*)g.Bt + (size_t)nxt.pn * tstep : cB;
        for (int t = 0; t < nt; t += 2) {
            const bool last = (t == nt - 2);
            const char* a1 = cA + (size_t)(t + 1) * kstep;
            const char* a2 = last ? nA : cA + (size_t)(t + 2) * kstep; const char* b2 = last ? nB : cB + (size_t)(t + 2) * kstep;
            const char* a3 = a2 + kstep; const char* b3 = b2 + kstep;
            PG8_LDB(B0, 0, 0); PG8_SCHED; PG8_LDA(At, 0, 0); PG8_STAGE(PG8_SA(1, 1), a1 + hstep, voffA);
            PG8_WAIT_L(8); PG8_BAR; PG8_WAIT_L(0); PG8_MMA(0, 0, At, B0); PG8_BAR; PG8_SCHED;
            PG8_LDB(B1, 0, 1); PG8_STAGE(PG8_SB(0, 0), b2, voffB);
            PG8_BAR; PG8_WAIT_L(0); PG8_MMA(0, 1, At, B1); PG8_BAR;
            PG8_LDA(At, 0, 1); PG8_STAGE(PG8_SA(0, 0), a2, voffA);
            PG8_BAR; PG8_WAIT_L(0); PG8_MMA(1, 0, At, B0); PG8_BAR; PG8_SCHED;
            PG8_STAGE(PG8_SB(0, 1), b2 + hstep, voffB);
            PG8_WAIT_V(6); PG8_BAR; PG8_MMA(1, 1, At, B1); PG8_BAR;
            PG8_LDB(B0, 1, 0); PG8_SCHED; PG8_LDA(At, 1, 0); PG8_STAGE(PG8_SA(0, 1), a2 + hstep, voffA);
            PG8_WAIT_L(8); PG8_BAR; PG8_WAIT_L(0); PG8_MMA(0, 0, At, B0); PG8_BAR; PG8_SCHED;
            PG8_LDB(B1, 1, 1); PG8_STAGE(PG8_SB(1, 0), b3, voffB);
            PG8_BAR; PG8_WAIT_L(0); PG8_MMA(0, 1, At, B1); PG8_BAR;
            PG8_LDA(At, 1, 1); PG8_STAGE(PG8_SA(1, 0), a3, voffA);
            PG8_BAR; PG8_WAIT_L(0); PG8_MMA(1, 0, At, B0); PG8_BAR; PG8_SCHED;
            PG8_STAGE(PG8_SB(1, 1), b3 + hstep, voffB);
            PG8_WAIT_V(6); PG8_BAR; PG8_MMA(1, 1, At, B1); PG8_BAR;
        }
        { int fr2 = lane_id_(), fq2; fq2 = fr2 >> 4; fr2 &= 15; asm volatile("" : "+v"(fr2), "+v"(fq2)); E(acc, cur, wr, wc, fr2, fq2); }
        if (!has_next) break;
#pragma unroll
        for (int a = 0; a < 2; ++a)
#pragma unroll
            for (int b = 0; b < 2; ++b)
#pragma unroll
                for (int m = 0; m < 4; ++m)
#pragma unroll
                    for (int n = 0; n < 2; ++n) acc[a][b][m][n] = (f32x4){0.f, 0.f, 0.f, 0.f};
        cur = nxt; cA = nA; cB = nB; ++ui;
    }
    PG8_WAIT_V(0);
    if (wr == 0) PG8_BAR;
    PG8_BAR;
#undef PG8_SA
#undef PG8_SB
#undef PG8_STAGE
#undef PG8_LDA
#undef PG8_LDB
#undef PG8_MMA
#undef PG8_WAIT_V
#undef PG8_WAIT_L
#undef PG8_SCHED
}

struct EpiPlainBf16 {
    static constexpr bool PERM = true;
    bf16_t* O; int ldc; int frag = 0; int fmin = 8;
    __device__ __forceinline__ void operator()(f32x4 (&acc)[2][2][4][2], const Unit& u, int wr, int wc, int fr, int fq) const {
        bf16_t* base; size_t s_ai, s_m, s_bj;
        if (frag && u.pn >= fmin) { base = O + ((size_t)(u.pm * frag + u.pn) << 16) + (size_t)((((wr * 4 + wc) * 16) * 64 + fq * 16 + fr) << 3); s_ai = 4096; s_m = 1024; s_bj = 512; }
        else if (frag) { base = O + ((size_t)(u.pm * frag + u.pn) << 16) + (size_t)(((wr * 64 + fr) << 8) + wc * 32 + 8 * fq); s_ai = (size_t)HALF * 256; s_m = 16 * 256; s_bj = HALF; }
        else { base = O + (size_t)(u.pm * BM + wr * 64 + fr) * ldc + u.pn * BM + wc * 32 + 8 * fq; s_ai = (size_t)HALF * ldc; s_m = (size_t)16 * ldc; s_bj = HALF; }
#pragma unroll
        for (int ai = 0; ai < 2; ++ai)
#pragma unroll
            for (int m = 0; m < 4; ++m)
#pragma unroll
                for (int bj = 0; bj < 2; ++bj) { const f32x4 v0 = acc[ai][bj][m][0], v1 = acc[ai][bj][m][1];
                    u32x4 w; w.x = cvt_pk_bf16(v0[0], v0[1]); w.y = cvt_pk_bf16(v0[2], v0[3]); w.z = cvt_pk_bf16(v1[0], v1[1]); w.w = cvt_pk_bf16(v1[2], v1[3]);
                    *(u32x4*)(base + ai * s_ai + m * s_m + bj * s_bj) = w; }
    }
};
struct EpiDummy {
    static constexpr bool PERM = true;
    float* O;
    __device__ __forceinline__ void operator()(f32x4 (&acc)[2][2][4][2], const Unit& u, int wr, int wc, int fr, int fq) const {
        float s = 0.f;
#pragma unroll
        for (int ai = 0; ai < 2; ++ai)
#pragma unroll
            for (int bj = 0; bj < 2; ++bj)
#pragma unroll
                for (int m = 0; m < 4; ++m)
#pragma unroll
                    for (int n = 0; n < 2; ++n) s += (acc[ai][bj][m][n][0] + acc[ai][bj][m][n][1]) + (acc[ai][bj][m][n][2] + acc[ai][bj][m][n][3]);
        if (s == 12345.678f) O[u.pm * 256 + fr] = s;
    }
};
__device__ __forceinline__ float row_rstd(const float* ssq, int row, int fq) {
    const f32x4 a = *(const f32x4*)(ssq + (size_t)row * 32 + 8 * fq), b = *(const f32x4*)(ssq + (size_t)row * 32 + 8 * fq + 4);
    float t = ((a[0] + a[1]) + (a[2] + a[3])) + ((b[0] + b[1]) + (b[2] + b[3]));
    t += __shfl_xor(t, 16); t += __shfl_xor(t, 32);
    return rsqrtf(t * (1.0f / 2048.0f) + EPS);
}
template <bool RB>
struct EpiResid {
    static constexpr bool PERM = true;
    const void* res; bf16_t* outb; float* ssq;
    __device__ __forceinline__ void operator()(f32x4 (&acc)[2][2][4][2], const Unit& u, int wr, int wc, int fr, int fq) const {
        const int row0 = u.pm * BM + wr * 64 + fr, col0 = u.pn * BM + wc * 32 + 8 * fq;
#pragma unroll
        for (int ai = 0; ai < 2; ++ai) {
            f32x4 r[4][2][2];
#pragma unroll
            for (int m = 0; m < 4; ++m)
#pragma unroll
                for (int bj = 0; bj < 2; ++bj) { const size_t o = (size_t)(row0 + ai * HALF + m * 16) * DM + col0 + bj * HALF;
                    if (RB) { const u32x4 w = *(const u32x4*)((const bf16_t*)res + o); r[m][bj][0] = (f32x4){bflo(w.x), bfhi(w.x), bflo(w.y), bfhi(w.y)}; r[m][bj][1] = (f32x4){bflo(w.z), bfhi(w.z), bflo(w.w), bfhi(w.w)}; }
                    else { r[m][bj][0] = *(const f32x4*)((const float*)res + o); r[m][bj][1] = *(const f32x4*)((const float*)res + o + 4); } }
#pragma unroll
            for (int m = 0; m < 4; ++m) { const int row = row0 + ai * HALF + m * 16; const size_t off = (size_t)row * DM + col0; float s = 0.f;
#pragma unroll
                for (int bj = 0; bj < 2; ++bj) { const f32x4 v0 = acc[ai][bj][m][0] + r[m][bj][0], v1 = acc[ai][bj][m][1] + r[m][bj][1];
                    u32x4 w; w.x = cvt_pk_bf16(v0[0], v0[1]); w.y = cvt_pk_bf16(v0[2], v0[3]); w.z = cvt_pk_bf16(v1[0], v1[1]); w.w = cvt_pk_bf16(v1[2], v1[3]);
                    *(u32x4*)(outb + off + bj * HALF) = w;
                    s += ((v0[0] * v0[0] + v0[1] * v0[1]) + (v0[2] * v0[2] + v0[3] * v0[3])) + ((v1[0] * v1[0] + v1[1] * v1[1]) + (v1[2] * v1[2] + v1[3] * v1[3])); }
                s += __shfl_xor(s, 16); s += __shfl_xor(s, 32);
                if (fq == 0) ssq[(size_t)row * 32 + u.pn * 4 + wc] = s; }
            asm volatile("" ::: "memory"); }
    }
};
struct EpiPle {
    static constexpr bool PERM = true;
    const float* ssq_in; const bf16_t* pp; const bf16_t* hb; bf16_t* out; float* ssq;
    __device__ __forceinline__ void operator()(f32x4 (&acc)[2][2][4][2], const Unit& u, int wr, int wc, int fr, int fq) const {
        const int row0 = u.pm * BM + wr * 64 + fr, col0 = u.pn * BM + wc * 32 + 8 * fq;
        const bf16_t* ppf = pp + ((size_t)(u.pm * (DM / 256) + u.pn) << 16) + (size_t)((((wr * 4 + wc) * 16) * 64 + fq * 16 + fr) << 3);
#pragma unroll
        for (int ai = 0; ai < 2; ++ai) {
            u32x4 hw[4][2], pw[4][2]; float rstd[4];
#pragma unroll
            for (int m = 0; m < 4; ++m) { const int row = row0 + ai * HALF + m * 16;
#pragma unroll
                for (int bj = 0; bj < 2; ++bj) { const size_t o = (size_t)row * DM + col0 + bj * HALF; hw[m][bj] = *(const u32x4*)(hb + o); pw[m][bj] = *(const u32x4*)(ppf + (((ai * 4 + m) * 2 + bj) << 9)); }
                rstd[m] = row_rstd(ssq_in, row, fq); }
#pragma unroll
            for (int m = 0; m < 4; ++m) { const int row = row0 + ai * HALF + m * 16; const size_t off = (size_t)row * DM + col0; float s = 0.f;
#pragma unroll
                for (int bj = 0; bj < 2; ++bj) { const f32x4 z0 = acc[ai][bj][m][0] * rstd[m], z1 = acc[ai][bj][m][1] * rstd[m]; const u32x4 h2 = hw[m][bj], p2 = pw[m][bj]; f32x4 v0, v1;
                    v0[0] = bflo(h2.x) + sigmoidf_(z0[0]) * bflo(p2.x); v0[1] = bfhi(h2.x) + sigmoidf_(z0[1]) * bfhi(p2.x);
                    v0[2] = bflo(h2.y) + sigmoidf_(z0[2]) * bflo(p2.y); v0[3] = bfhi(h2.y) + sigmoidf_(z0[3]) * bfhi(p2.y);
                    v1[0] = bflo(h2.z) + sigmoidf_(z1[0]) * bflo(p2.z); v1[1] = bfhi(h2.z) + sigmoidf_(z1[1]) * bfhi(p2.z);
                    v1[2] = bflo(h2.w) + sigmoidf_(z1[2]) * bflo(p2.w); v1[3] = bfhi(h2.w) + sigmoidf_(z1[3]) * bfhi(p2.w);
                    u32x4 w; w.x = cvt_pk_bf16(v0[0], v0[1]); w.y = cvt_pk_bf16(v0[2], v0[3]); w.z = cvt_pk_bf16(v1[0], v1[1]); w.w = cvt_pk_bf16(v1[2], v1[3]);
                    *(u32x4*)(out + off + bj * HALF) = w;
                    s += ((v0[0] * v0[0] + v0[1] * v0[1]) + (v0[2] * v0[2] + v0[3] * v0[3])) + ((v1[0] * v1[0] + v1[1] * v1[1]) + (v1[2] * v1[2] + v1[3] * v1[3])); }
                s += __shfl_xor(s, 16); s += __shfl_xor(s, 32);
                if (fq == 0) ssq[(size_t)row * 32 + u.pn * 4 + wc] = s; }
            asm volatile("" ::: "memory"); }
    }
};
struct EpiConv {
    static constexpr bool PERM = false;
    const float* ssq_in; const float* cw; const float* cb; bf16_t* act; float* uedge; LAS float* ex; LAS float* cws; LAS float* rsl;
    __device__ __forceinline__ void conv_rows(const f32x4 curg, const f32x4 curv, f32x4 (&q1)[2], f32x4 (&q2)[2], const LAS float* cp, bf16_t* dst, const bool upd) const {
        f32x4 uc[2];
#pragma unroll
        for (int bj = 0; bj < 2; ++bj) {
            const f32x4 c0 = *(const LAS f32x4*)(cp + bj * 32), c1 = *(const LAS f32x4*)(cp + bj * 32 + 64), c2 = *(const LAS f32x4*)(cp + bj * 32 + 128), bb = *(const LAS f32x4*)(cp + bj * 32 + 192);
            const f32x4 cur = bj ? curv : curg;
#pragma unroll
            for (int e = 0; e < 4; ++e) {
                const float p1 = dpp_shr1(q1[bj][e], cur[e]), p2 = dpp_shr2(q2[bj][e], cur[e]);
                uc[bj][e] = bb[e] + c0[e] * p2 + c1[e] * p1 + c2[e] * cur[e];
                if (upd) { q1[bj][e] = dpp_ror1(cur[e]); q2[bj][e] = dpp_ror2(cur[e]); }
            }
        }
        u32x2 w;
        { const float a0 = uc[0][0] * sigmoidf_(uc[0][0]) * uc[1][0], a1 = uc[0][1] * sigmoidf_(uc[0][1]) * uc[1][1];
          const float a2 = uc[0][2] * sigmoidf_(uc[0][2]) * uc[1][2], a3 = uc[0][3] * sigmoidf_(uc[0][3]) * uc[1][3];
          w.x = cvt_pk_bf16(a0, a1); w.y = cvt_pk_bf16(a2, a3); }
        *(u32x2*)dst = w;
    }
    __device__ __forceinline__ void operator()(f32x4 (&acc)[2][2][4][2], const Unit& u, int wr, int wc, int fr, int fq) const {
        const int rowt = u.pm * BM + wr * 64 + fr, cl0 = wc * 32 + 4 * fq, wv = wr * 4 + wc, ln = fq * 16 + fr;
        float cwr[4];
#pragma unroll
        for (int i = 0; i < 4; ++i) { const float* srcp = (i < 3) ? (cw + (size_t)i * FF2) : cb; cwr[i] = srcp[(ln >> 5) * FF + u.pn * HALF + wc * 32 + (ln & 31)]; }
        {
            LAS float* myr = rsl + wv * 128; LAS int* mypm = (LAS int*)(rsl + 1024) + wv;
            if (__builtin_amdgcn_readfirstlane(*mypm) != u.pm) {
#pragma unroll
                for (int ai = 0; ai < 2; ++ai)
#pragma unroll
                    for (int m = 0; m < 4; ++m) { const float r_ = row_rstd(ssq_in, rowt + ai * HALF + m * 16, fq); if (fq == 0) myr[(ai * 4 + m) * 16 + fr] = r_; }
                if (fq == 0 && fr == 0) *mypm = u.pm;
                asm volatile("s_waitcnt lgkmcnt(0)" ::: "memory");
            }
#pragma unroll
            for (int ai = 0; ai < 2; ++ai)
#pragma unroll
                for (int m = 0; m < 4; ++m) { const float rstd = myr[(ai * 4 + m) * 16 + fr];
#pragma unroll
                    for (int bj = 0; bj < 2; ++bj)
#pragma unroll
                        for (int n = 0; n < 2; ++n) acc[ai][bj][m][n] *= rstd; }
        }
        if (fr >= 14) {
#pragma unroll
            for (int ai = 0; ai < 2; ++ai)
#pragma unroll
                for (int bj = 0; bj < 2; ++bj)
#pragma unroll
                    for (int n = 0; n < 2; ++n) *(LAS f32x4*)(ex + (((ai * 2 + wr) * 2 + (fr - 14)) * 256 + bj * HALF + cl0 + n * 16)) = acc[ai][bj][3][n];
        }
        if (wr == 0 && fr < 2) {
#pragma unroll
            for (int bj = 0; bj < 2; ++bj)
#pragma unroll
                for (int n = 0; n < 2; ++n) *(f32x4*)(uedge + ((size_t)(u.pm * 4 + fr) * FF2 + u.pn * BM + bj * HALF + cl0 + n * 16)) = acc[0][bj][0][n];
        }
        if (wr == 1 && fr >= 14) {
#pragma unroll
            for (int bj = 0; bj < 2; ++bj)
#pragma unroll
                for (int n = 0; n < 2; ++n) *(f32x4*)(uedge + ((size_t)(u.pm * 4 + 2 + (fr - 14)) * FF2 + u.pn * BM + bj * HALF + cl0 + n * 16)) = acc[1][bj][3][n];
        }
        LAS float* myc = cws + wv * 256;
#pragma unroll
        for (int i = 0; i < 4; ++i) myc[i * 64 + ln] = cwr[i];
        asm volatile("s_waitcnt lgkmcnt(0)" ::: "memory");
#pragma unroll
        for (int n = 0; n < 2; ++n) {
            const int jcol = u.pn * HALF + cl0 + n * 16; const LAS float* cp = myc + 16 * n + 4 * fq;
#pragma unroll
            for (int ai = 0; ai < 2; ++ai) {
                f32x4 q1[2], q2[2];
#pragma unroll
                for (int bj = 0; bj < 2; ++bj)
#pragma unroll
                    for (int e = 0; e < 4; ++e) { q1[bj][e] = dpp_ror1(acc[ai][bj][0][n][e]); q2[bj][e] = dpp_ror2(acc[ai][bj][0][n][e]); }
#pragma unroll
                for (int m = 1; m < 4; ++m) conv_rows(acc[ai][0][m][n], acc[ai][1][m][n], q1, q2, cp, act + (size_t)(rowt + ai * HALF + m * 16) * FF + jcol, m < 3);
            }
        }
        asm volatile("s_waitcnt lgkmcnt(0)" ::: "memory"); PG8_BAR; PG8_BAR; asm volatile("" ::: "memory");
#pragma unroll
        for (int n = 0; n < 2; ++n) {
            const int jcol = u.pn * HALF + cl0 + n * 16; const LAS float* cp = myc + 16 * n + 4 * fq;
#pragma unroll
            for (int ai = 0; ai < 2; ++ai) {
                const bool has_prev = !(ai == 0 && wr == 0);
                const int slot = (wr == 1) ? (ai * 2) : ((ai - 1) * 2 + 1);
                f32x4 q1[2], q2[2];
#pragma unroll
                for (int bj = 0; bj < 2; ++bj) {
                    f32x4 e0 = (f32x4){0.f, 0.f, 0.f, 0.f}, e1 = (f32x4){0.f, 0.f, 0.f, 0.f};
                    if (has_prev) { e0 = *(const LAS f32x4*)(ex + ((slot * 2 + 0) * 256 + bj * HALF + cl0 + n * 16)); e1 = *(const LAS f32x4*)(ex + ((slot * 2 + 1) * 256 + bj * HALF + cl0 + n * 16)); }
                    q1[bj] = e1;
#pragma unroll
                    for (int e = 0; e < 4; ++e) q2[bj][e] = (fr == 1) ? e1[e] : e0[e];
                }
                conv_rows(acc[ai][0][0][n], acc[ai][1][0][n], q1, q2, cp, act + (size_t)(rowt + ai * HALF) * FF + jcol, false);
            }
        }
    }
};
#undef PG8_BAR
}

__device__ void phase0(const Params& p, LAS unsigned char* lds, const int WID) {
    unsigned char* ws = p.ws;
    const int G = gridDim.x, bx = blockIdx.x, wid = WID, lane = lane_id_(), tid = wid * 64 + lane;
    { const float* x = p.in[0]; const float* gm = p.in[2]; bf16_t* xa = (bf16_t*)(ws + WS_XA);
      for (int r = bx * 8 + wid; r < MTOK; r += G * 8) { const float* xr = x + (size_t)r * DM; f32x4 v[8]; float s = 0.f;
#pragma unroll
          for (int i = 0; i < 8; ++i) { v[i] = *(const f32x4*)(xr + i * 256 + lane * 4); s += (v[i][0] * v[i][0] + v[i][1] * v[i][1]) + (v[i][2] * v[i][2] + v[i][3] * v[i][3]); }
#pragma unroll
          for (int o = 32; o >= 1; o >>= 1) s += __shfl_xor(s, o);
          const float rstd = rsqrtf(s * (1.0f / 2048.0f) + EPS);
#pragma unroll
          for (int i = 0; i < 8; ++i) { const f32x4 gv = *(const f32x4*)(gm + i * 256 + lane * 4); u32x2 w; w.x = cvt_pk_bf16(v[i][0] * rstd * gv[0], v[i][1] * rstd * gv[1]); w.y = cvt_pk_bf16(v[i][2] * rstd * gv[2], v[i][3] * rstd * gv[3]);
              *(u32x2*)(xa + (size_t)r * DM + i * 256 + lane * 4) = w; } } }
    { const float* pin = p.in[1]; bf16_t* pb = (bf16_t*)(ws + WS_PB);
      for (int i = bx * 512 + tid; i < MTOK * PLE / 4; i += G * 512) { const f32x4 v = *(const f32x4*)(pin + (size_t)i * 4); u32x2 w; w.x = cvt_pk_bf16(v[0], v[1]); w.y = cvt_pk_bf16(v[2], v[3]); *(u32x2*)(pb + (size_t)i * 4) = w; } }
    constexpr int J0 = 16 * 112, J1 = J0 + 16 * 32, J2 = J1 + 16 * 176, J3 = J2 + 44 * 32, J4 = J3 + 16 * 32, J5 = J4 + 2 * 32;
    const float* src = nullptr; bf16_t* dst = nullptr; const float* scale = nullptr; int K = 0, N = 0, mode = 0, k0 = 0, n0 = 0;
#define P0_DECODE(job) do { int tp_; \
        if ((job) < J0) { src = p.in[3]; dst = (bf16_t*)(ws + WS_WIN); scale = nullptr; K = DM; N = INC; mode = 0; tp_ = (job); } \
        else if ((job) < J1) { src = p.in[7]; dst = (bf16_t*)(ws + WS_WOUT); scale = nullptr; K = DM; N = DM; mode = 0; tp_ = (job) - J0; } \
        else if ((job) < J2) { src = p.in[9]; dst = (bf16_t*)(ws + WS_WUP); scale = p.in[8]; K = DM; N = FF2; mode = 1; tp_ = (job) - J1; } \
        else if ((job) < J3) { src = p.in[12]; dst = (bf16_t*)(ws + WS_WDOWN); scale = nullptr; K = FF; N = DM; mode = 0; tp_ = (job) - J2; } \
        else if ((job) < J4) { src = p.in[14]; dst = (bf16_t*)(ws + WS_WGATE); scale = p.in[13]; K = DM; N = DM; mode = 0; tp_ = (job) - J3; } \
        else { src = p.in[15]; dst = (bf16_t*)(ws + WS_WPROJ); scale = nullptr; K = PLE; N = DM; mode = 0; tp_ = (job) - J4; } \
        const int nk2_ = K >> 7; k0 = (tp_ % nk2_) * 128; n0 = (tp_ / nk2_) * 64; } while (0)
#define P0_LOAD() do { _Pragma("unroll") for (int i_ = 0; i_ < 4; ++i_) { const int kk_ = (tid >> 4) + 32 * i_; \
        v[i_] = *(const f32x4*)(src + (size_t)(k0 + kk_) * N + n0 + (tid & 15) * 4); sc[i_] = scale ? scale[k0 + kk_] : 1.0f; } } while (0)
    f32x4 v[4]; float sc[4];
    int job = bx, buf = 0;
    if (job < J5) { P0_DECODE(job); P0_LOAD(); }
    __syncthreads();
    while (job < J5) {
        LAS bf16_t* tl = (LAS bf16_t*)(lds + buf * 17408);
        const int nn = (tid & 15) * 4;
#pragma unroll
        for (int i = 0; i < 4; ++i) { const int kk = (tid >> 4) + 32 * i; const unsigned w0 = cvt_pk_bf16(v[i][0] * sc[i], v[i][1] * sc[i]), w1 = cvt_pk_bf16(v[i][2] * sc[i], v[i][3] * sc[i]);
            tl[(nn + 0) * 136 + kk] = (bf16_t)(w0 & 0xffff); tl[(nn + 1) * 136 + kk] = (bf16_t)(w0 >> 16); tl[(nn + 2) * 136 + kk] = (bf16_t)(w1 & 0xffff); tl[(nn + 3) * 136 + kk] = (bf16_t)(w1 >> 16); }
        bf16_t* cdst = dst; const int cK = K, cmode = mode, ck0 = k0, cn0 = n0;
        const int nxt = job + G;
        if (nxt < J5) { P0_DECODE(nxt); P0_LOAD(); }
        __syncthreads();
        { const int n = tid >> 3, kc = (tid & 7) * 16; const LAS unsigned char* rp = lds + buf * 17408 + n * 272 + kc * 2;
          const u32x4 w0 = *(const LAS u32x4*)rp, w1 = *(const LAS u32x4*)(rp + 16);
          int R = cn0 + n;
          if (cmode == 1) { const int j = (R < FF) ? R : R - FF; R = 256 * (j >> 7) + (j & 127) + ((cn0 + n < FF) ? 0 : 128); }
          bf16_t* op = cdst + (size_t)R * cK + ck0 + kc; *(u32x4*)op = w0; *(u32x4*)(op + 8) = w1; }
        job = nxt; buf ^= 1;
    }
#undef P0_DECODE
#undef P0_LOAD
    __syncthreads();
}

__device__ __forceinline__ void attn_softmax(f32x4 (&sc)[4], float& m_run, float& l_run, f32x4 (&o)[8], const int j, const int tq, const int g, const LAS float* tb, bf16x8 (&pb)[2]) {
    const float SC = 0.08838834764831845f * LOG2E;
    float mx = m_run;
    if (j <= 5) { const float bc = tb[256];
#pragma unroll
        for (int mt = 0; mt < 4; ++mt)
#pragma unroll
            for (int e = 0; e < 4; ++e) { sc[mt][e] = sc[mt][e] * SC + bc; mx = fmaxf(mx, sc[mt][e]); } }
    else { const int relb = tq + 64 * (8 - j) - 4 * g;
#pragma unroll
        for (int mt = 0; mt < 4; ++mt)
#pragma unroll
            for (int e = 0; e < 4; ++e) { int rel = relb - 16 * mt - e; rel = rel > 128 ? 128 : rel; sc[mt][e] = sc[mt][e] * SC + tb[rel + 128]; mx = fmaxf(mx, sc[mt][e]); } }
    mx = fmaxf(mx, __shfl_xor(mx, 16)); mx = fmaxf(mx, __shfl_xor(mx, 32));
    mx = (mx - m_run > 8.0f) ? mx : m_run;
    const float alpha = __builtin_amdgcn_exp2f(m_run - mx); m_run = mx;
    float ls = 0.f;
#pragma unroll
    for (int mt = 0; mt < 4; ++mt)
#pragma unroll
        for (int e = 0; e < 4; ++e) { sc[mt][e] = __builtin_amdgcn_exp2f(sc[mt][e] - mx); ls += sc[mt][e]; }
    l_run = l_run * alpha + ls;
    if (__builtin_amdgcn_ballot_w64(alpha != 1.0f) != 0ull) {
#pragma unroll
        for (int cc = 0; cc < 8; ++cc) o[cc] *= alpha;
    }
#pragma unroll
    for (int s2 = 0; s2 < 2; ++s2) { u32x4 pw; pw.x = cvt_pk_bf16(sc[2 * s2][0], sc[2 * s2][1]); pw.y = cvt_pk_bf16(sc[2 * s2][2], sc[2 * s2][3]);
        pw.z = cvt_pk_bf16(sc[2 * s2 + 1][0], sc[2 * s2 + 1][1]); pw.w = cvt_pk_bf16(sc[2 * s2 + 1][2], sc[2 * s2 + 1][3]); pb[s2] = __builtin_bit_cast(bf16x8, pw); }
}
__device__ void attn_quad(const bf16_t* proj, const float* rel_bias, bf16_t* ycat, int quad, LAS unsigned char* lds, const int WID) {
    const int tid = TID_X, grp = WID >> 2, wq = WID & 3, lane = tid & 63, g = lane >> 4, li = lane & 15;
    const int bh = quad >> 4, c0 = (quad & 15) * 4, h = bh & 7, b = bh >> 3;
    const int kA = 2 * grp, kB = kA + 1;
    const int tokq = b * SEQ + c0 * 64;
    LAS float* tb = (LAS float*)(lds + 65536);
    __syncthreads();
    for (int i = tid; i < 257; i += 512) tb[i] = rel_bias[h * 257 + i] * LOG2E;
    bf16x8 qfA[4], qfB[4];
    { const int qr = tokq + kA * 64 + 16 * wq + li, qc = 4096 + 128 * h + 8 * g;
#pragma unroll
      for (int ks = 0; ks < 4; ++ks) { qfA[ks] = *(const bf16x8*)(proj + proj_off_fr(qr, qc + 32 * ks)); qfB[ks] = *(const bf16x8*)(proj + proj_off_fr(qr + 64, qc + 32 * ks)); } }
    float mA = -1e30f, lA = 0.f, mB = -1e30f, lB = 0.f; f32x4 oA[8], oB[8];
#pragma unroll
    for (int cc = 0; cc < 8; ++cc) { oA[cc] = (f32x4){0.f, 0.f, 0.f, 0.f}; oB[cc] = (f32x4){0.f, 0.f, 0.f, 0.f}; }
    const int u0 = (8 - c0) > 0 ? (8 - c0) : 0;
    const int srow = 16 * (WID & 3) + (tid & 15), sch = 4 * (WID >> 2) + ((tid >> 4) & 3);
    u32x4 kr0[2], vr0[2], kr1[2], vr1[2];
    const bf16_t* kb0 = proj + proj_off_fr(tokq - 512 + srow, 5120 + 128 * h + 8 * sch); const bf16_t* vb0 = proj + proj_off_fr(tokq - 512 + srow, 6144 + 128 * h + 8 * sch);
#define ATT_LOAD(u_, KR, VR) do { const long _o = (long)((u_) >> 2) * (28L << 16) + ((u_) & 1) * 32768 + (((u_) >> 1) & 1) * 4096; _Pragma("unroll") for (int _i = 0; _i < 2; ++_i) { \
        KR[_i] = *(const u32x4*)(kb0 + _o + _i * 16384); VR[_i] = *(const u32x4*)(vb0 + _o + _i * 16384); } } while (0)
#define ATT_STORE(buf_, KR, VR) do { _Pragma("unroll") for (int _i = 0; _i < 2; ++_i) { const unsigned ob_ = off_b(srow, sch + 8 * _i); \
        *(LAS u32x4*)(lds + (buf_) * 32768 + ob_) = KR[_i]; *(LAS u32x4*)(lds + (buf_) * 32768 + 16384 + ob_) = VR[_i]; } } while (0)
    const int tq = 16 * wq + li;
    const unsigned trq = (unsigned)(li >> 2), trp = (unsigned)(li & 3);
#define ATT_COMPUTE(u) do { \
        LAS unsigned char* Kimg = lds + buf * 32768; LAS unsigned char* Vimg = Kimg + 16384; \
        const bool actA = ((u) >= kA) && ((u) <= kA + 8), actB = ((u) >= kB) && ((u) <= kB + 8); \
        if (actA || actB) { \
            f32x4 sA[4], sB[4]; \
            _Pragma("unroll") for (int mt = 0; mt < 4; ++mt) { sA[mt] = (f32x4){0.f, 0.f, 0.f, 0.f}; sB[mt] = (f32x4){0.f, 0.f, 0.f, 0.f}; \
                _Pragma("unroll") for (int ks = 0; ks < 4; ++ks) { const bf16x8 a = *(const LAS bf16x8*)(Kimg + off_b(16 * mt + li, 4 * ks + g)); \
                    if (actA) sA[mt] = __builtin_amdgcn_mfma_f32_16x16x32_bf16(a, qfA[ks], sA[mt], 0, 0, 0); \
                    if (actB) sB[mt] = __builtin_amdgcn_mfma_f32_16x16x32_bf16(a, qfB[ks], sB[mt], 0, 0, 0); } } \
            bf16x8 pbA[2], pbB[2]; \
            pbA[0] = pbA[1] = pbB[0] = pbB[1] = (bf16x8){0, 0, 0, 0, 0, 0, 0, 0}; \
            if (actA) attn_softmax(sA, mA, lA, oA, (u) - kA, tq, g, tb, pbA); \
            if (actB) attn_softmax(sB, mB, lB, oB, (u) - kB, tq, g, tb, pbB); \
            _Pragma("unroll") for (int s2 = 0; s2 < 2; ++s2) { const unsigned r0 = 32 * s2 + 4 * g + trq, r1 = r0 + 16; \
                _Pragma("unroll") for (int cc = 0; cc < 8; ++cc) { \
                    const s16x4 lo = tr_read(Vimg + off_b(r0, 2 * cc + (trp >> 1)) + 8 * (trp & 1)), hi = tr_read(Vimg + off_b(r1, 2 * cc + (trp >> 1)) + 8 * (trp & 1)); \
                    const bf16x8 vf = cat8(lo, hi); \
                    if (actA) oA[cc] = __builtin_amdgcn_mfma_f32_16x16x32_bf16(vf, pbA[s2], oA[cc], 0, 0, 0); \
                    if (actB) oB[cc] = __builtin_amdgcn_mfma_f32_16x16x32_bf16(vf, pbB[s2], oB[cc], 0, 0, 0); \
                } } \
        } } while (0)
    ATT_LOAD(u0, kr0, vr0); ATT_LOAD(u0 + 1, kr1, vr1); ATT_STORE(0, kr0, vr0);
    __syncthreads();
    int buf = 0;
    for (int u = u0; u < 12; u += 2) {
        if (u + 2 < 12) ATT_LOAD(u + 2, kr0, vr0);
        ATT_COMPUTE(u);
        ATT_STORE(buf ^ 1, kr1, vr1);
        __syncthreads(); buf ^= 1;
        if (u + 3 < 12) ATT_LOAD(u + 3, kr1, vr1);
        ATT_COMPUTE(u + 1);
        if (u + 2 < 12) ATT_STORE(buf ^ 1, kr0, vr0);
        __syncthreads(); buf ^= 1;
    }
#undef ATT_COMPUTE
#undef ATT_LOAD
#undef ATT_STORE
    lA += __shfl_xor(lA, 16); lA += __shfl_xor(lA, 32); lB += __shfl_xor(lB, 16); lB += __shfl_xor(lB, 32);
    const float invA = 1.0f / lA, invB = 1.0f / lB;
    bf16_t* yp = ycat + (size_t)(tokq + kA * 64 + tq) * DM + 1024 + 128 * h + 4 * g;
#pragma unroll
    for (int cc = 0; cc < 8; ++cc) { u32x2 w; w.x = cvt_pk_bf16(oA[cc][0] * invA, oA[cc][1] * invA); w.y = cvt_pk_bf16(oA[cc][2] * invA, oA[cc][3] * invA); *(u32x2*)(yp + 16 * cc) = w;
        u32x2 w2; w2.x = cvt_pk_bf16(oB[cc][0] * invB, oB[cc][1] * invB); w2.y = cvt_pk_bf16(oB[cc][2] * invB, oB[cc][3] * invB); *(u32x2*)(yp + (size_t)64 * DM + 16 * cc) = w2; }
}

constexpr int HG_K = 0, HG_V = 16384, HG_Q1 = 32768, HG_Q2 = 49152, HG_S = 65536, HG_TOT = 98304, HG_RED = 102400;

__device__ void hgrn_state_loop(const bf16_t* proj, const float* lbl, float* ust, float* ddec, int task, const int stride, const int ntask, LAS unsigned char* lds, const int WID) {
    const int wid = WID, lane = lane_id_(), tid = wid * 64 + lane, g = lane >> 4, li = lane & 15;
    const int dp = tid & 63, sq = tid >> 6, d0 = 2 * dp;
    LAS float* tot = (LAS float*)(lds + HG_TOT);
    const unsigned trq = (unsigned)(li >> 2), trp = (unsigned)(li & 3);
    const int vrow = 16 * (wid & 3) + li, vch = 4 * (wid >> 2) + g;
    unsigned fw[8]; u32x4 vr[2]; float lbv[4];
#define H1_LOAD(task_) do { const int c_ = (task_) & 63, bh_ = (task_) >> 6, h_ = bh_ & 7, b_ = bh_ >> 3; const int tok_ = b_ * SEQ + c_ * 64; \
        lbv[0] = lbl[128 * h_ + d0]; lbv[1] = lbl[128 * h_ + d0 + 1]; lbv[2] = lbl[1024 + 128 * h_ + d0]; lbv[3] = lbl[1024 + 128 * h_ + d0 + 1]; \
        { const bf16_t* fb_ = proj + proj_off_rm(tok_ + 8 * sq, 1024 + 128 * h_ + d0); _Pragma("unroll") for (int i_ = 0; i_ < 8; ++i_) fw[i_] = *(const unsigned*)(fb_ + i_ * 256); } \
        { const bf16_t* vb_ = proj + proj_off_fr(tok_ + vrow, 2048 + 128 * h_ + 8 * vch); _Pragma("unroll") for (int i_ = 0; i_ < 2; ++i_) vr[i_] = *(const u32x4*)(vb_ + i_ * 16384); } } while (0)
    if (task < ntask) H1_LOAD(task);
    while (task < ntask) {
        const int c = task & 63, bh = task >> 6;
        const int ci = bh * 64 + c;
        __syncthreads();
        float lb[2];
        lb[0] = __builtin_amdgcn_rcpf(1.0f + __expf(lbv[2] - lbv[0])); lb[1] = __builtin_amdgcn_rcpf(1.0f + __expf(lbv[3] - lbv[1]));
        float cs[8][2], kg[8][2];
        { float run0 = 0.f, run1 = 0.f;
#pragma unroll
          for (int i = 0; i < 8; ++i) { const unsigned w = fw[i];
              const float s0 = sigmoidf_(bflo(w)), s1 = sigmoidf_(bfhi(w));
              run0 += __logf(lb[0] + (1.0f - lb[0]) * s0); run1 += __logf(lb[1] + (1.0f - lb[1]) * s1);
              cs[i][0] = run0; cs[i][1] = run1; kg[i][0] = (1.0f - lb[0]) * (1.0f - s0); kg[i][1] = (1.0f - lb[1]) * (1.0f - s1); }
          tot[sq * 128 + d0] = run0; tot[sq * 128 + d0 + 1] = run1; }
#pragma unroll
        for (int i = 0; i < 2; ++i) *(LAS u32x4*)(lds + HG_V + off_b(vrow, vch + 8 * i)) = vr[i];
        const int nxt = task + stride;
        if (nxt < ntask) H1_LOAD(nxt);
        __syncthreads();
        float pre0 = 0.f, pre1 = 0.f, bl0 = 0.f, bl1 = 0.f;
#pragma unroll
        for (int q = 0; q < 8; ++q) { const float t0 = tot[q * 128 + d0], t1 = tot[q * 128 + d0 + 1]; if (q < sq) { pre0 += t0; pre1 += t1; } bl0 += t0; bl1 += t1; }
#pragma unroll
        for (int i = 0; i < 8; ++i) { const int s_ = 8 * sq + i; const float k0 = kg[i][0] * __expf(bl0 - (pre0 + cs[i][0])), k1 = kg[i][1] * __expf(bl1 - (pre1 + cs[i][1]));
            *(LAS unsigned*)(lds + HG_K + off_b(s_, dp >> 2) + (dp & 3) * 4) = cvt_pk_bf16(k0, k1); }
        if (sq == 0) { f32x2 dv; dv.x = __expf(bl0); dv.y = __expf(bl1); *(f32x2*)(ddec + (size_t)ci * 128 + d0) = dv; }
        __syncthreads();
        f32x4 acc[8];
#pragma unroll
        for (int nt = 0; nt < 8; ++nt) acc[nt] = (f32x4){0.f, 0.f, 0.f, 0.f};
#pragma unroll
        for (int ks = 0; ks < 2; ++ks) {
            const unsigned r0 = 32 * ks + 8 * g + trq, r1 = r0 + 4;
            const bf16x8 a = cat8(tr_read(lds + HG_K + off_b(r0, 2 * wid + (trp >> 1)) + 8 * (trp & 1)), tr_read(lds + HG_K + off_b(r1, 2 * wid + (trp >> 1)) + 8 * (trp & 1)));
#pragma unroll
            for (int nt = 0; nt < 8; ++nt) {
                const bf16x8 bb = cat8(tr_read(lds + HG_V + off_b(r0, 2 * nt + (trp >> 1)) + 8 * (trp & 1)), tr_read(lds + HG_V + off_b(r1, 2 * nt + (trp >> 1)) + 8 * (trp & 1)));
                acc[nt] = __builtin_amdgcn_mfma_f32_16x16x32_bf16(a, bb, acc[nt], 0, 0, 0);
            }
        }
        bf16_t* up = (bf16_t*)ust + (size_t)ci * 16384 + 16 * wid + 4 * g;
#pragma unroll
        for (int nt = 0; nt < 8; ++nt) { u32x2 w; w.x = cvt_pk_bf16(acc[nt][0], acc[nt][1]); w.y = cvt_pk_bf16(acc[nt][2], acc[nt][3]); *(u32x2*)(up + (size_t)(16 * nt + li) * 128) = w; }
        task = nxt;
    }
#undef H1_LOAD
}

__device__ void hgrn_scan(const float* ust, const float* ddec, bf16_t* sst, const int WID) {
    for (int e4 = blockIdx.x * 512 + TID_X; e4 < 32 * 4096; e4 += gridDim.x * 512) {
        const int bh = e4 >> 12, off = (e4 & 4095) * 4, d = off & 127;
        f32x4 S = (f32x4){0.f, 0.f, 0.f, 0.f};
        const bf16_t* up = (const bf16_t*)ust + (size_t)bh * 64 * 16384 + off; const float* dp = ddec + (size_t)bh * 64 * 128 + d; bf16_t* sp = sst + (size_t)bh * 64 * 16384 + off;
#pragma unroll 16
        for (int c = 0; c < 64; ++c) {
            const u32x2 uw = *(const u32x2*)(up + (size_t)c * 16384); const f32x4 U = (f32x4){bflo(uw.x), bfhi(uw.x), bflo(uw.y), bfhi(uw.y)}; const f32x4 Dv = *(const f32x4*)(dp + c * 128);
            u32x2 w; w.x = cvt_pk_bf16(S[0], S[1]); w.y = cvt_pk_bf16(S[2], S[3]); *(u32x2*)(sp + (size_t)c * 16384) = w;
            S = Dv * S + U;
        }
    }
}

__device__ void hgrn_out_loop(const bf16_t* proj, const float* lbl, const bf16_t* sst, const float* hgn, bf16_t* ycat, int task, const int stride, const int ntask, LAS unsigned char* lds, const int WID) {
    const int wid = WID, lane = lane_id_(), tid = wid * 64 + lane, g = lane >> 4, li = lane & 15;
    const int dp = tid & 63, sq = tid >> 6, d0 = 2 * dp;
    const int nt = wid & 3, vh = wid >> 2, tloc = 16 * nt + li;
    LAS float* tot = (LAS float*)(lds + HG_TOT);
    LAS float* red = (LAS float*)(lds + HG_RED);
    const unsigned trq = (unsigned)(li >> 2), trp = (unsigned)(li & 3);
    const int vrow = 16 * (wid & 3) + li, vch = 4 * (wid >> 2) + g;
    f32x4 nv[4];
#pragma unroll
    for (int vt = 0; vt < 4; ++vt) nv[vt] = *(const f32x4*)(hgn + 16 * (4 * vh + vt) + 4 * g);
    unsigned fw[8], qw[8]; u32x4 vr[2], sr[4]; u32x2 gw[4], gwn[4]; float lbv[4];
#define H3_LOAD(task_, GW) do { const int c_ = (task_) & 63, bh_ = (task_) >> 6, h_ = bh_ & 7, b_ = bh_ >> 3; const int tok_ = b_ * SEQ + c_ * 64; const size_t ci_ = (size_t)(bh_ * 64 + c_); \
        lbv[0] = lbl[128 * h_ + d0]; lbv[1] = lbl[128 * h_ + d0 + 1]; lbv[2] = lbl[1024 + 128 * h_ + d0]; lbv[3] = lbl[1024 + 128 * h_ + d0 + 1]; \
        { const bf16_t* qb_ = proj + proj_off_rm(tok_ + 8 * sq, 128 * h_ + d0); _Pragma("unroll") for (int i_ = 0; i_ < 8; ++i_) { fw[i_] = *(const unsigned*)(qb_ + (4L << 16) + i_ * 256); qw[i_] = *(const unsigned*)(qb_ + i_ * 256); } } \
        { const bf16_t* vb_ = proj + proj_off_fr(tok_ + vrow, 2048 + 128 * h_ + 8 * vch); _Pragma("unroll") for (int i_ = 0; i_ < 2; ++i_) vr[i_] = *(const u32x4*)(vb_ + i_ * 16384); } \
        _Pragma("unroll") for (int i_ = 0; i_ < 4; ++i_) { const int n_ = tid + 512 * i_; sr[i_] = *(const u32x4*)(sst + ci_ * 16384 + (n_ >> 4) * 128 + 8 * (n_ & 15)); } \
        { const bf16_t* gb_ = proj + proj_off_fr(tok_ + tloc, 3072 + 128 * h_ + 4 * g + 64 * vh); _Pragma("unroll") for (int vt_ = 0; vt_ < 4; ++vt_) GW[vt_] = *(const u32x2*)(gb_ + (vt_ & 1) * 256 + (vt_ >> 1) * 8192); } } while (0)
    if (task < ntask) H3_LOAD(task, gw);
    while (task < ntask) {
        const int c = task & 63, bh = task >> 6, h = bh & 7, b = bh >> 3;
        const int tok0 = b * SEQ + c * 64;
        __syncthreads();
        float lb[2];
        lb[0] = __builtin_amdgcn_rcpf(1.0f + __expf(lbv[2] - lbv[0])); lb[1] = __builtin_amdgcn_rcpf(1.0f + __expf(lbv[3] - lbv[1]));
        float cs[8][2], kg[8][2], qs[8][2];
        { float run0 = 0.f, run1 = 0.f;
#pragma unroll
          for (int i = 0; i < 8; ++i) { const unsigned w = fw[i], wq_ = qw[i];
              const float s0 = sigmoidf_(bflo(w)), s1 = sigmoidf_(bfhi(w));
              run0 += __logf(lb[0] + (1.0f - lb[0]) * s0); run1 += __logf(lb[1] + (1.0f - lb[1]) * s1);
              cs[i][0] = run0; cs[i][1] = run1; kg[i][0] = (1.0f - lb[0]) * (1.0f - s0); kg[i][1] = (1.0f - lb[1]) * (1.0f - s1);
              const float q0 = bflo(wq_), q1 = bfhi(wq_); qs[i][0] = q0 * sigmoidf_(q0); qs[i][1] = q1 * sigmoidf_(q1); }
          tot[sq * 128 + d0] = run0; tot[sq * 128 + d0 + 1] = run1; }
#pragma unroll
        for (int i = 0; i < 2; ++i) *(LAS u32x4*)(lds + HG_V + off_b(vrow, vch + 8 * i)) = vr[i];
#pragma unroll
        for (int i = 0; i < 4; ++i) { const int n = tid + 512 * i; *(LAS u32x4*)(lds + HG_S + off_b(n >> 4, n & 15)) = sr[i]; }
        __syncthreads();
        { float pre0 = 0.f, pre1 = 0.f, bm0 = 0.f, bm1 = 0.f;
#pragma unroll
          for (int q = 0; q < 8; ++q) { const float t0 = tot[q * 128 + d0], t1 = tot[q * 128 + d0 + 1]; if (q < sq) { pre0 += t0; pre1 += t1; } if (q < 4) { bm0 += t0; bm1 += t1; } }
#pragma unroll
          for (int i = 0; i < 8; ++i) { const int s_ = 8 * sq + i; const float b0 = pre0 + cs[i][0], b1 = pre1 + cs[i][1];
              const unsigned o_ = off_b(s_, dp >> 2) + (dp & 3) * 4;
              *(LAS unsigned*)(lds + HG_K + o_) = cvt_pk_bf16(kg[i][0] * __expf(bm0 - b0), kg[i][1] * __expf(bm1 - b1));
              *(LAS unsigned*)(lds + HG_Q1 + o_) = cvt_pk_bf16(qs[i][0] * __expf(b0 - bm0), qs[i][1] * __expf(b1 - bm1));
              *(LAS unsigned*)(lds + HG_Q2 + o_) = cvt_pk_bf16(qs[i][0] * __expf(b0), qs[i][1] * __expf(b1)); } }
        const int nxt = task + stride;
        if (nxt < ntask) H3_LOAD(nxt, gwn);
        __syncthreads();
        bf16x8 q1f[4], q2f[4];
#pragma unroll
        for (int ks = 0; ks < 4; ++ks) { q1f[ks] = *(const LAS bf16x8*)(lds + HG_Q1 + off_b(16 * nt + li, 4 * ks + g)); q2f[ks] = *(const LAS bf16x8*)(lds + HG_Q2 + off_b(16 * nt + li, 4 * ks + g)); }
        f32x4 sc[4];
#pragma unroll
        for (int mt = 0; mt < 4; ++mt) { sc[mt] = (f32x4){0.f, 0.f, 0.f, 0.f};
            if (mt <= nt) {
#pragma unroll
                for (int ks = 0; ks < 4; ++ks) { const bf16x8 a = *(const LAS bf16x8*)(lds + HG_K + off_b(16 * mt + li, 4 * ks + g)); sc[mt] = __builtin_amdgcn_mfma_f32_16x16x32_bf16(a, q1f[ks], sc[mt], 0, 0, 0); }
#pragma unroll
                for (int e = 0; e < 4; ++e) { const int s_ = 16 * mt + 4 * g + e; sc[mt][e] = (s_ <= tloc) ? sc[mt][e] : 0.f; }
            } }
        bf16x8 pb[2];
#pragma unroll
        for (int s2 = 0; s2 < 2; ++s2) { u32x4 pw; pw.x = cvt_pk_bf16(sc[2 * s2][0], sc[2 * s2][1]); pw.y = cvt_pk_bf16(sc[2 * s2][2], sc[2 * s2][3]);
            pw.z = cvt_pk_bf16(sc[2 * s2 + 1][0], sc[2 * s2 + 1][1]); pw.w = cvt_pk_bf16(sc[2 * s2 + 1][2], sc[2 * s2 + 1][3]); pb[s2] = __builtin_bit_cast(bf16x8, pw); }
        f32x4 o[4];
#pragma unroll
        for (int vt = 0; vt < 4; ++vt) { o[vt] = (f32x4){0.f, 0.f, 0.f, 0.f}; const int vtile = 4 * vh + vt;
#pragma unroll
            for (int ks = 0; ks < 4; ++ks) { const bf16x8 a = *(const LAS bf16x8*)(lds + HG_S + off_b(16 * vtile + li, 4 * ks + g)); o[vt] = __builtin_amdgcn_mfma_f32_16x16x32_bf16(a, q2f[ks], o[vt], 0, 0, 0); }
#pragma unroll
            for (int s2 = 0; s2 < 2; ++s2) { const unsigned r0 = 32 * s2 + 4 * g + trq, r1 = r0 + 16;
                const bf16x8 a = cat8(tr_read(lds + HG_V + off_b(r0, 2 * vtile + (trp >> 1)) + 8 * (trp & 1)), tr_read(lds + HG_V + off_b(r1, 2 * vtile + (trp >> 1)) + 8 * (trp & 1)));
                o[vt] = __builtin_amdgcn_mfma_f32_16x16x32_bf16(a, pb[s2], o[vt], 0, 0, 0); }
        }
        float ss = 0.f;
#pragma unroll
        for (int vt = 0; vt < 4; ++vt) ss += (o[vt][0] * o[vt][0] + o[vt][1] * o[vt][1]) + (o[vt][2] * o[vt][2] + o[vt][3] * o[vt][3]);
        ss += __shfl_xor(ss, 16); ss += __shfl_xor(ss, 32);
        if (g == 0) red[wid * 16 + li] = ss;
        __syncthreads();
        const float tot2 = red[wid * 16 + li] + red[(wid ^ 4) * 16 + li];
        const float rstd = rsqrtf(tot2 * (1.0f / 128.0f) + EPS);
        bf16_t* yp = ycat + (size_t)(tok0 + tloc) * DM + 128 * h + 4 * g;
#pragma unroll
        for (int vt = 0; vt < 4; ++vt) { const int v0 = 16 * (4 * vh + vt); const u32x2 gwv = gw[vt];
            const float g0 = bflo(gwv.x), g1 = bfhi(gwv.x), g2 = bflo(gwv.y), g3 = bfhi(gwv.y);
            u32x2 w; w.x = cvt_pk_bf16(o[vt][0] * rstd * nv[vt][0] * g0 * sigmoidf_(g0), o[vt][1] * rstd * nv[vt][1] * g1 * sigmoidf_(g1));
            w.y = cvt_pk_bf16(o[vt][2] * rstd * nv[vt][2] * g2 * sigmoidf_(g2), o[vt][3] * rstd * nv[vt][3] * g3 * sigmoidf_(g3));
            *(u32x2*)(yp + v0) = w; }
#pragma unroll
        for (int vt = 0; vt < 4; ++vt) gw[vt] = gwn[vt];
        task = nxt;
    }
#undef H3_LOAD
}

__device__ void conv_fixup(const float* uedge, const float* cw, const float* cb, bf16_t* act, int pm, const int WID) {
    const bool hp = (pm & 15) != 0;
    const float* e = uedge + (size_t)pm * 4 * FF2; const float* ep = uedge + (size_t)(pm - 1) * 4 * FF2;
    for (int idx = TID_X; idx < 2 * FF; idx += 512) {
        const int r = idx / FF, j = idx - r * FF; const int cg_ = 256 * (j >> 7) + (j & 127);
        float uc[2];
#pragma unroll
        for (int bj = 0; bj < 2; ++bj) { const int cc = cg_ + 128 * bj, no = j + FF * bj;
            const float u0 = e[cc], u1 = e[FF2 + cc];
            const float p254 = hp ? ep[2 * FF2 + cc] : 0.f, p255 = hp ? ep[3 * FF2 + cc] : 0.f;
            const float c0 = cw[no], c1 = cw[FF2 + no], c2 = cw[2 * FF2 + no], bb = cb[no];
            uc[bj] = (r == 0) ? (bb + c2 * u0 + c1 * p255 + c0 * p254) : (bb + c2 * u1 + c1 * u0 + c0 * p255); }
        const float a = uc[0] * sigmoidf_(uc[0]) * uc[1];
        act[(size_t)(pm * 256 + r) * FF + j] = (bf16_t)(cvt_pk_bf16(a, 0.f) & 0xffff);
    }
}

#ifndef REP_P0
#define REP_P0 1
#endif
#ifndef REP_ATT
#define REP_ATT 1
#endif
#ifndef REP_H1
#define REP_H1 1
#endif
#ifndef REP_H2
#define REP_H2 1
#endif
#ifndef REP_H3
#define REP_H3 1
#endif
#ifndef REP_G1
#define REP_G1 1
#endif
#ifndef REP_G2
#define REP_G2 1
#endif
#ifndef REP_GPP
#define REP_GPP 1
#endif
#ifndef REP_G3
#define REP_G3 1
#endif
#ifndef REP_DUMMY
#define REP_DUMMY 0
#endif
#ifndef REP_SYNC
#define REP_SYNC 1
#endif
#define GSYNC() do { for (int s_ = 0; s_ < REP_SYNC; ++s_) xcd_barrier(xb, WID); } while (0)
__global__ void __launch_bounds__(512) mega(Params p) {
    extern __shared__ __attribute__((aligned(16))) unsigned char lds_raw[];
    LAS unsigned char* lds = (LAS unsigned char*)lds_raw;
    cg::grid_group grid = cg::this_grid();
    unsigned char* ws = p.ws;
    const int G = gridDim.x, bx = blockIdx.x;
    const int WID = __builtin_amdgcn_readfirstlane(threadIdx.x >> 6);
    volatile LAS unsigned* stw = (volatile LAS unsigned*)(lds + LDS_BYTES - 16);
    XcdBarrier xb; xb.bar = (unsigned*)(ws + WS_BAR); xb.x = xb_xcc_id(); xb.st = stw;
    if (threadIdx.x == 0) { stw[0] = 0u; stw[1] = 0u; stw[2] = xb_add(&xb.bar[XB_XCNT(xb.x)], 1u); stw[3] = 0u; }
    bf16_t* proj = (bf16_t*)(ws + WS_PROJ); bf16_t* ycat = (bf16_t*)(ws + WS_YCAT);

    for (int r_ = 0; r_ < REP_P0; ++r_) phase0(p, lds, WID);
    grid.sync();
    if (WID == 0 && lane_id_() == 0) { bool uni = (G == 256);
        for (int j = 0; j < 16; ++j) { const unsigned cnt = xb_ld(&xb.bar[XB_XCNT(j)]); uni = uni && (cnt == (j < 8 ? 32u : 0u)); }
        stw[3] = uni ? 1u : 0u; }
    __syncthreads();
    const bool uni_ = __builtin_amdgcn_readfirstlane((int)stw[3]) != 0; const int rank_ = __builtin_amdgcn_readfirstlane((int)stw[2]);
    const int cg_ = uni_ ? (rank_ * 8 + (int)xb.x) : bx, cl_ = uni_ ? ((int)xb.x * 32 + rank_) : bx;
    { pg8::Gemm g{(const bf16_t*)(ws + WS_XA), (const bf16_t*)(ws + WS_WIN), MTOK, INC, DM}; pg8::StaticOrder S; S.init(MTOK, INC, G, cg_);
      pg8::EpiPlainBf16 E{proj, INC, INC / 256}; for (int r_ = 0; r_ < REP_G1; ++r_) pg8::gemm_phase(WID, lds, g, S, E);
      pg8::EpiDummy ED{p.out}; for (int r_ = 0; r_ < REP_DUMMY; ++r_) pg8::gemm_phase<pg8::EpiDummy, true>(WID, lds, g, S, ED); }
    GSYNC();
    for (int r_ = 0; r_ < REP_H1; ++r_)
    hgrn_state_loop(proj, p.in[4], p.out, (float*)(ws + WS_DDEC), cl_, G, 2048, lds, WID);
    GSYNC();
    for (int st = 0; st < 2; ++st) {
        if ((st == 0) == ((cl_ & 1) == 0)) {
            for (int r_ = 0; r_ < REP_ATT; ++r_)
            for (int q = cl_; q < 512; q += G) attn_quad(proj, p.in[6], ycat, q, lds, WID);
        } else {
            for (int r_ = 0; r_ < REP_H2; ++r_)
            hgrn_scan(p.out, (const float*)(ws + WS_DDEC), (bf16_t*)(ws + WS_SST), WID);
        }
    }
    GSYNC();
    for (int r_ = 0; r_ < REP_H3; ++r_)
    hgrn_out_loop(proj, p.in[4], (const bf16_t*)(ws + WS_SST), p.in[5], ycat, cl_, G, 2048, lds, WID);
    GSYNC();
    { pg8::Gemm g{ycat, (const bf16_t*)(ws + WS_WOUT), MTOK, DM, DM}; pg8::StaticOrder S; S.init(MTOK, DM, G, cg_);
      pg8::EpiResid<false> E{p.in[0], (bf16_t*)(ws + WS_H1B), (float*)(ws + WS_SSQ1)}; for (int r_ = 0; r_ < REP_G2; ++r_) pg8::gemm_phase(WID, lds, g, S, E); }
    { pg8::Gemm g{(const bf16_t*)(ws + WS_PB), (const bf16_t*)(ws + WS_WPROJ), MTOK, DM, PLE}; pg8::StaticOrder S; S.init(MTOK, DM, G, cg_);
      pg8::EpiPlainBf16 E{(bf16_t*)(ws + WS_PP), DM, DM / 256, 0};     for (int r_ = 0; r_ < REP_GPP; ++r_) pg8::gemm_phase(WID, lds, g, S, E); }
    GSYNC();
    { pg8::Gemm g{(const bf16_t*)(ws + WS_H1B), (const bf16_t*)(ws + WS_WUP), MTOK, FF2, DM}; pg8::StaticOrder S; S.init(MTOK, FF2, G, cg_);
      pg8::EpiConv E{(const float*)(ws + WS_SSQ1), p.in[10], p.in[11], (bf16_t*)(ws + WS_ACT), (float*)(ws + WS_UEDGE), (LAS float*)(lds + pg8::STAGE_BYTES), (LAS float*)(lds + pg8::STAGE_BYTES + 8192), (LAS float*)(lds + pg8::STAGE_BYTES + 16384)};
      if (lane_id_() == 0) ((LAS int*)(lds + pg8::STAGE_BYTES + 16384 + 4096))[WID] = -1;
      __syncthreads();
      for (int r_ = 0; r_ < REP_G3; ++r_) pg8::gemm_phase(WID, lds, g, S, E); }
    GSYNC();
    { pg8::StaticOrder S; S.init(MTOK, DM, G, cg_); pg8::Unit u; int last = -1;
      for (int i = 0; S.next(i, u); ++i) if (u.pm != last) { conv_fixup((const float*)(ws + WS_UEDGE), p.in[10], p.in[11], (bf16_t*)(ws + WS_ACT), u.pm, WID); last = u.pm; }
      __threadfence(); __syncthreads();
      pg8::Gemm g{(const bf16_t*)(ws + WS_ACT), (const bf16_t*)(ws + WS_WDOWN), MTOK, DM, FF};
      pg8::EpiResid<true> E{(const void*)(ws + WS_H1B), (bf16_t*)(ws + WS_H1B), (float*)(ws + WS_SSQ2)}; pg8::gemm_phase(WID, lds, g, S, E); }
    GSYNC();
    { pg8::Gemm g{(const bf16_t*)(ws + WS_H1B), (const bf16_t*)(ws + WS_WGATE), MTOK, DM, DM}; pg8::StaticOrder S; S.init(MTOK, DM, G, cg_);
      pg8::EpiPle E{(const float*)(ws + WS_SSQ2), (const bf16_t*)(ws + WS_PP), (const bf16_t*)(ws + WS_H1B), (bf16_t*)(ws + WS_ACT), (float*)(ws + WS_SSQ3)}; pg8::gemm_phase(WID, lds, g, S, E); }
    GSYNC();
    { const int wid = WID, lane = lane_id_(); const float* fn = p.in[16]; const float* ssq = (const float*)(ws + WS_SSQ3); const bf16_t* h3b = (const bf16_t*)(ws + WS_ACT);
      for (int r = bx * 8 + wid; r < MTOK; r += G * 8) { float* xr = p.out + (size_t)r * DM; const bf16_t* hr = h3b + (size_t)r * DM;
          u32x4 hv[4];
#pragma unroll
          for (int i = 0; i < 4; ++i) hv[i] = *(const u32x4*)(hr + i * 512 + lane * 8);
          float s = (lane < 32) ? ssq[(size_t)r * 32 + lane] : 0.f;
#pragma unroll
          for (int o = 32; o >= 1; o >>= 1) s += __shfl_xor(s, o);
          const float rstd = rsqrtf(s * (1.0f / 2048.0f) + EPS);
#pragma unroll
          for (int i = 0; i < 4; ++i) { const f32x4 g0 = *(const f32x4*)(fn + i * 512 + lane * 8), g1 = *(const f32x4*)(fn + i * 512 + lane * 8 + 4);
              f32x4 a, b2; a[0] = bflo(hv[i].x) * rstd * g0[0]; a[1] = bfhi(hv[i].x) * rstd * g0[1]; a[2] = bflo(hv[i].y) * rstd * g0[2]; a[3] = bfhi(hv[i].y) * rstd * g0[3];
              b2[0] = bflo(hv[i].z) * rstd * g1[0]; b2[1] = bfhi(hv[i].z) * rstd * g1[1]; b2[2] = bflo(hv[i].w) * rstd * g1[2]; b2[3] = bfhi(hv[i].w) * rstd * g1[3];
              *(f32x4*)(xr + i * 512 + lane * 8) = a; *(f32x4*)(xr + i * 512 + lane * 8 + 4) = b2; } } }
}

extern "C" void kernel_launch(void* const* d_in, const int* in_sizes, int n_in, void* d_out, int out_size, void* d_ws, size_t ws_size, hipStream_t stream) {
    static int grid = 0;
    if (grid == 0) {
        if (n_in != 17 || out_size != MTOK * DM || ws_size < WS_END) { fprintf(stderr, "kernel_launch: unexpected shapes (n_in %d out %d ws %zu)\n", n_in, out_size, ws_size); grid = -1; return; }
        int dev = 0, cus = 0, per_cu = 0;
        (void)hipGetDevice(&dev);
        (void)hipDeviceGetAttribute(&cus, hipDeviceAttributeMultiprocessorCount, dev);
        if (hipFuncSetAttribute((const void*)mega, hipFuncAttributeMaxDynamicSharedMemorySize, LDS_BYTES) != hipSuccess) { fprintf(stderr, "hipFuncSetAttribute failed\n"); grid = -1; return; }
        if (hipOccupancyMaxActiveBlocksPerMultiprocessor(&per_cu, (const void*)mega, 512, LDS_BYTES) != hipSuccess || per_cu < 1) { fprintf(stderr, "occupancy query: %d\n", per_cu); (void)hipGetLastError(); grid = -1; return; }
        grid = cus;
    }
    if (grid < 0) return;
    Params p{};
    for (int i = 0; i < 17; ++i) p.in[i] = (const float*)d_in[i];
    p.out = (float*)d_out; p.ws = (unsigned char*)d_ws;
    void* args[] = {&p};
    if (hipMemsetAsync((unsigned char*)d_ws + WS_BAR, 0, XCD_BAR_WORDS * 4, stream) != hipSuccess) { fprintf(stderr, "memset failed\n"); return; }
    hipError_t e = hipLaunchCooperativeKernel((const void*)mega, dim3(grid), dim3(512), args, LDS_BYTES, stream);
    if (e != hipSuccess) fprintf(stderr, "cooperative launch failed: %s\n", hipGetErrorString(e));
}
```

```cpp
#include <hip/hip_runtime.h>
#include <hip/hip_cooperative_groups.h>
#include <cstdio>
namespace cg = cooperative_groups;

#define LAS __attribute__((address_space(3)))
typedef unsigned short bf16_t;
typedef short bf16x8 __attribute__((ext_vector_type(8)));
typedef short s16x4 __attribute__((ext_vector_type(4)));
typedef float f32x4 __attribute__((ext_vector_type(4)));
typedef float f32x2 __attribute__((ext_vector_type(2)));
typedef unsigned u32x4 __attribute__((ext_vector_type(4)));
typedef unsigned u32x2 __attribute__((ext_vector_type(2)));

constexpr int MTOK = 16384, DM = 2048, INC = 7168, FF = 5632, FF2 = 11264, PLE = 256, SEQ = 4096;
constexpr int LDS_BYTES = 149 * 1024;
constexpr float EPS = 1e-6f;
constexpr float LOG2E = 1.4426950408889634f;

constexpr size_t MiB = 1048576;
constexpr size_t WS_WIN = 0, WS_WOUT = 28 * MiB, WS_WUP = 36 * MiB, WS_WDOWN = 80 * MiB, WS_WGATE = 102 * MiB, WS_WPROJ = 110 * MiB;
constexpr size_t WS_PROJ = 111 * MiB;
constexpr size_t WS_XA = 335 * MiB;
constexpr size_t WS_YCAT = 335 * MiB;
constexpr size_t WS_SST = 399 * MiB;
constexpr size_t WS_DDEC = 463 * MiB;
constexpr size_t WS_SSQ1 = 464 * MiB, WS_SSQ2 = 466 * MiB, WS_SSQ3 = 468 * MiB;
constexpr size_t WS_PB = 470 * MiB;
constexpr size_t WS_H1B = 111 * MiB;
constexpr size_t WS_PP = 175 * MiB;
constexpr size_t WS_ACT = 239 * MiB;
constexpr size_t WS_UEDGE = 415 * MiB;
constexpr size_t WS_BAR = 478 * MiB;
constexpr size_t WS_END = 479 * MiB;

struct Params { const float* in[17]; float* out; unsigned char* ws; };

__device__ __forceinline__ unsigned cvt_pk_bf16(float lo, float hi) { unsigned r; asm volatile("v_cvt_pk_bf16_f32 %0, %1, %2" : "=v"(r) : "v"(lo), "v"(hi)); return r; }
__device__ __forceinline__ float bf2f(unsigned short b) { return __uint_as_float(((unsigned)b) << 16); }
__device__ __forceinline__ float bflo(unsigned w) { return __uint_as_float(w << 16); }
__device__ __forceinline__ float bfhi(unsigned w) { return __uint_as_float(w & 0xffff0000u); }
__device__ __forceinline__ float sigmoidf_(float x) { return __builtin_amdgcn_rcpf(1.0f + __expf(-x)); }
__device__ __forceinline__ size_t proj_off(int row, int col) {
    const int rl = row & 255, cl = col & 255; const size_t tb = (size_t)((row >> 8) * 28 + (col >> 8)) << 16;
    if (col < 2048) return tb + (size_t)((rl << 8) + cl);
    const int wv = ((rl >> 6) & 1) * 4 + ((cl >> 5) & 3), k = (((rl >> 7) & 1) * 4 + ((rl >> 4) & 3)) * 2 + ((cl >> 7) & 1), ln = ((cl >> 3) & 3) * 16 + (rl & 15);
    return tb + (size_t)((((wv * 16 + k) * 64 + ln) << 3) + (cl & 7));
}
__device__ __forceinline__ long proj_off_rm(int row, int col) { return ((long)((row >> 8) * 28 + (col >> 8)) << 16) + (long)(((row & 255) << 8) + (col & 255)); }
__device__ __forceinline__ long proj_off_fr(int row, int col) {
    const int rl = row & 255, cl = col & 255;
    const int wv = ((rl >> 6) & 1) * 4 + ((cl >> 5) & 3), k = (((rl >> 7) & 1) * 4 + ((rl >> 4) & 3)) * 2 + ((cl >> 7) & 1), ln = ((cl >> 3) & 3) * 16 + (rl & 15);
    return ((long)((row >> 8) * 28 + (col >> 8)) << 16) + (long)((((wv * 16 + k) * 64 + ln) << 3) + (cl & 7));
}
__device__ __forceinline__ unsigned off_b(unsigned row, unsigned ch) { return 256u * row + 16u * (ch ^ (((row & 3u) << 2) | ((row >> 2) & 3u))); }
__device__ __forceinline__ s16x4 tr_read(LAS unsigned char* p) { return __builtin_bit_cast(s16x4, __builtin_amdgcn_ds_read_tr16_b64_v4i16((LAS s16x4*)p)); }
__device__ __forceinline__ bf16x8 cat8(s16x4 a, s16x4 b) { return (bf16x8){a[0], a[1], a[2], a[3], b[0], b[1], b[2], b[3]}; }
__device__ __forceinline__ float dpp_ror1(float v) { return __int_as_float(__builtin_amdgcn_update_dpp(0, __float_as_int(v), 0x121, 0xf, 0xf, false)); }
__device__ __forceinline__ float dpp_shr1(float old, float v) { return __int_as_float(__builtin_amdgcn_update_dpp(__float_as_int(old), __float_as_int(v), 0x111, 0xf, 0xf, false)); }
__device__ __forceinline__ float dpp_shr2(float old, float v) { return __int_as_float(__builtin_amdgcn_update_dpp(__float_as_int(old), __float_as_int(v), 0x112, 0xf, 0xf, false)); }
__device__ __forceinline__ float dpp_ror2(float v) { return __int_as_float(__builtin_amdgcn_update_dpp(0, __float_as_int(v), 0x122, 0xf, 0xf, false)); }

__device__ __forceinline__ int lane_id_() { int l; asm volatile("v_mbcnt_lo_u32_b32 %0, -1, 0\n\tv_mbcnt_hi_u32_b32 %0, -1, %0" : "=v"(l)); return l; }
#define TID_X (WID * 64 + lane_id_())

#define XB_TMO      128
#define XB_XCNT(j)  (256  + 64 * (j))
#define XB_XSUB(j)  (1280 + 64 * (j))
#define XB_XGEN(j)  (2304 + 64 * (j))
#define XB_TOP      3328
#define XB_TOPGEN   3392
#define XCD_BAR_WORDS 3456
#define XB_SPIN_CAP (1u << 18)
__device__ __forceinline__ unsigned xb_ld(unsigned* p)              { return __hip_atomic_load(p, __ATOMIC_RELAXED, __HIP_MEMORY_SCOPE_AGENT); }
__device__ __forceinline__ unsigned xb_add(unsigned* p, unsigned v) { return __hip_atomic_fetch_add(p, v, __ATOMIC_RELAXED, __HIP_MEMORY_SCOPE_AGENT); }
__device__ __forceinline__ unsigned xb_xcc_id() { return (unsigned)__builtin_amdgcn_s_getreg((3 << 11) | 20) & 0xFu; }
#define XB_SPIN(cond, bar) do { unsigned _sp = 0; while (cond) { __builtin_amdgcn_s_sleep(1); \
    if ((++_sp & 255u) == 0u) { if (xb_ld(&(bar)[XB_TMO])) break; if (_sp > XB_SPIN_CAP) { atomicAdd(&(bar)[XB_TMO], 1u); break; } } } } while (0)
struct XcdBarrier { unsigned* bar; unsigned x; volatile LAS unsigned* st; };
__device__ __forceinline__ void xcd_barrier_complete(unsigned* bar, unsigned x, unsigned& nloc, unsigned& nx) {
    const unsigned G = gridDim.x;
    unsigned sum, cnt, mine, sp = 0u;
    for (;;) {
        sum = 0u; cnt = 0u; mine = 0u;
#pragma unroll
        for (unsigned j = 0; j < 16; ++j) { const unsigned c = xb_ld(&bar[XB_XCNT(j)]); sum += c; cnt += (c > 0u) ? 1u : 0u; mine = (j == x) ? c : mine; }
        if (sum == G) break;
        __builtin_amdgcn_s_sleep(1);
        if ((++sp & 255u) == 0u) { if (xb_ld(&bar[XB_TMO])) break; if (sp > XB_SPIN_CAP) { atomicAdd(&bar[XB_TMO], 1u); break; } }
    }
    nloc = mine > 0u ? mine : 1u; nx = cnt > 0u ? cnt : 1u;
}
__device__ __forceinline__ void xcd_barrier(const XcdBarrier& b, const int WID) {
    asm volatile("s_waitcnt vmcnt(0)" ::: "memory");
    __syncthreads();
    if (WID == 0 && lane_id_() == 0) {
        unsigned* bar = b.bar;
        __builtin_amdgcn_s_waitcnt(0);
        unsigned nloc = b.st[0], nx = b.st[1];
        if (nloc == 0u) { xcd_barrier_complete(bar, b.x, nloc, nx); b.st[0] = nloc; b.st[1] = nx; }
        const unsigned old = xb_add(&bar[XB_XSUB(b.x)], 1u);
        const unsigned gen = old / nloc;
        if (old + 1u == (gen + 1u) * nloc) {
            __builtin_amdgcn_fence(__ATOMIC_RELEASE, "agent");
            asm volatile("s_waitcnt vmcnt(0)" ::: "memory");
            const unsigned og = xb_add(&bar[XB_TOP], 1u);
            const unsigned tg = og / nx;
            if (og + 1u == (tg + 1u) * nx) xb_add(&bar[XB_TOPGEN], 1u);
            else XB_SPIN(xb_ld(&bar[XB_TOPGEN]) == tg, bar);
            __builtin_amdgcn_fence(__ATOMIC_ACQUIRE, "agent");
            xb_add(&bar[XB_XGEN(b.x)], 1u);
            asm volatile("s_waitcnt vmcnt(0)" ::: "memory");
        } else {
            XB_SPIN(xb_ld(&bar[XB_XGEN(b.x)]) == gen, bar);
            __builtin_amdgcn_fence(__ATOMIC_ACQUIRE, "agent");
            asm volatile("s_waitcnt vmcnt(0)" ::: "memory");
        }
    }
    __syncthreads();
}

namespace pg8 {
constexpr int BM = 256, BK = 64, HALF = 128, HTB = HALF * BK * 2, STAGE_BYTES = 8 * HTB, NXCD = 8, WGM = 8;
__device__ __forceinline__ int lds_byte(int r, int c) { const int st = (r >> 4) * 2 + (c >> 5), rr = r & 15, cc = c & 31, ob = rr * 64 + cc * 2; return st * 1024 + (ob ^ (((ob >> 9) & 1) << 5)); }
__device__ __forceinline__ void stage_rc(int b, int& R, int& C) { const int st = b / 1024, sb = b % 1024, swz = sb ^ (((sb >> 9) & 1) << 5); R = (st >> 1) * 16 + swz / 64; C = (st & 1) * 32 + (swz % 64) / 2; }
__device__ __forceinline__ int perm32(int rho) { const int n = rho >> 4, i = rho & 15; return 8 * (i >> 2) + 4 * n + (i & 3); }
struct Unit { int pm, pn; };
struct Gemm { const bf16_t* A; const bf16_t* Bt; int M, N, K; };
struct StaticOrder {
    int nM, nN, nwg, G, c;
    __device__ void init(int M, int N, int G_, int c_) { nM = M / BM; nN = N / BM; nwg = nM * nN; G = G_; c = c_; }
    __device__ bool next(int i, Unit& u) const {
        const long L = (long)i * G + c; if (L >= nwg) return false;
        int wgid = (int)L; { const int q = nwg / NXCD, r = nwg % NXCD, xcd = wgid % NXCD, off = wgid / NXCD; wgid = (xcd < r ? xcd * (q + 1) : r * (q + 1) + (xcd - r) * q) + off; }
        const int nig = WGM * nN, gid = wgid / nig, fm = gid * WGM, gsz = (nM - fm) < WGM ? (nM - fm) : WGM;
        u.pm = fm + ((wgid % nig) % gsz); u.pn = (wgid % nig) / gsz; return true;
    }
};

template <class Epi, bool KS0 = false>
__device__ __forceinline__ void gemm_phase(const int WID, LAS unsigned char* lds, const Gemm g, const StaticOrder& S, const Epi& E) {
    const int wid = WID, lane = lane_id_(), tid = wid * 64 + lane, wr = wid >> 2, wc = wid & 3, fr = lane & 15, fq = lane >> 4;
    const int K = g.K, nt = K / BK;
    unsigned voffA[2], voffB[2];
#pragma unroll
    for (int i = 0; i < 2; ++i) { int R, C; stage_rc(tid * 16 + i * 8192, R, C); const int Rb = Epi::PERM ? ((R & ~31) + perm32(R & 31)) : R;
        voffA[i] = (unsigned)(R * K + C) * 2u; voffB[i] = (unsigned)(Rb * K + C) * 2u; }
    const size_t kstep = KS0 ? (size_t)0 : (size_t)(BK * 2);
    const size_t hstep = (size_t)HALF * K * 2;
    const size_t tstep = 2 * hstep;
    const unsigned ldsw = (unsigned)wid * 1024u;
    const int aoff = lds_byte(wr * 64 + fr, fq * 8), boff = lds_byte(wc * 32 + fr, fq * 8);
#define PG8_SA(b, h) (((b) * 2 + (h)) * HTB)
#define PG8_SB(b, h) ((4 + (b) * 2 + (h)) * HTB)
#define PG8_STAGE(bufoff, gbase, voff) do { _Pragma("unroll") for (int _i = 0; _i < 2; ++_i) \
        __builtin_amdgcn_global_load_lds((const unsigned*)((const char*)(gbase) + (voff)[_i]), (LAS unsigned*)(lds + (bufoff) + ldsw + _i * 8192), 16, 0, 0); } while (0)
#define PG8_LDA(dst, b, h) do { _Pragma("unroll") for (int m = 0; m < 4; ++m) _Pragma("unroll") for (int k = 0; k < 2; ++k) dst[m][k] = *(const LAS bf16x8*)(lds + PG8_SA(b, h) + aoff + m * 2048 + k * 1024); } while (0)
#define PG8_LDB(dst, b, h) do { _Pragma("unroll") for (int n = 0; n < 2; ++n) _Pragma("unroll") for (int k = 0; k < 2; ++k) dst[n][k] = *(const LAS bf16x8*)(lds + PG8_SB(b, h) + boff + n * 2048 + k * 1024); } while (0)
#define PG8_MMA(ai, bj, At, Bt) do { __builtin_amdgcn_s_setprio(1); _Pragma("unroll") for (int m = 0; m < 4; ++m) _Pragma("unroll") for (int n = 0; n < 2; ++n) _Pragma("unroll") for (int k = 0; k < 2; ++k) \
        acc[ai][bj][m][n] = __builtin_amdgcn_mfma_f32_16x16x32_bf16(Bt[n][k], At[m][k], acc[ai][bj][m][n], 0, 0, 0); __builtin_amdgcn_s_setprio(0); } while (0)
#define PG8_WAIT_V(n) asm volatile("s_waitcnt vmcnt(" #n ")" ::: "memory")
#define PG8_WAIT_L(n) asm volatile("s_waitcnt lgkmcnt(" #n ")" ::: "memory")
#define PG8_BAR __builtin_amdgcn_s_barrier()
#define PG8_SCHED __builtin_amdgcn_sched_barrier(0)
    Unit cur, nxt; int ui = 0;
    if (!S.next(0, cur)) return;
    f32x4 acc[2][2][4][2];
#pragma unroll
    for (int a = 0; a < 2; ++a)
#pragma unroll
        for (int b = 0; b < 2; ++b)
#pragma unroll
            for (int m = 0; m < 4; ++m)
#pragma unroll
                for (int n = 0; n < 2; ++n) acc[a][b][m][n] = (f32x4){0.f, 0.f, 0.f, 0.f};
    bf16x8 At[4][2], B0[2][2], B1[2][2];
    const char* cA = (const char*)g.A + (size_t)cur.pm * tstep; const char* cB = (const char*)g.Bt + (size_t)cur.pn * tstep;
    PG8_STAGE(PG8_SB(0, 0), cB, voffB); PG8_STAGE(PG8_SA(0, 0), cA, voffA); PG8_STAGE(PG8_SB(0, 1), cB + hstep, voffB); PG8_STAGE(PG8_SA(0, 1), cA + hstep, voffA);
    if (wr == 1) PG8_BAR;
    PG8_WAIT_V(4); PG8_BAR;
    PG8_STAGE(PG8_SB(1, 0), cB + kstep, voffB); PG8_STAGE(PG8_SA(1, 0), cA + kstep, voffA); PG8_STAGE(PG8_SB(1, 1), cB + hstep + kstep, voffB);
    PG8_WAIT_V(6); PG8_BAR;
    for (;;) {
        const bool has_next = S.next(ui + 1, nxt);
        const char* nA = has_next ? (const char*)g.A + (size_t)nxt.pm * tstep : cA; const char* nB = has_next ? (const char*)g.Bt + (size_t)nxt.pn * tstep : cB;
        for (int t = 0; t < nt; t += 2) {
            const bool last = (t == nt - 2);
            const char* a1 = cA + (size_t)(t + 1) * kstep;
            const char* a2 = last ? nA : cA + (size_t)(t + 2) * kstep; const char* b2 = last ? nB : cB + (size_t)(t + 2) * kstep;
            const char* a3 = a2 + kstep; const char* b3 = b2 + kstep;
            PG8_LDB(B0, 0, 0); PG8_SCHED; PG8_LDA(At, 0, 0); PG8_STAGE(PG8_SA(1, 1), a1 + hstep, voffA);
            PG8_WAIT_L(8); PG8_BAR; PG8_WAIT_L(0); PG8_MMA(0, 0, At, B0); PG8_BAR; PG8_SCHED;
            PG8_LDB(B1, 0, 1); PG8_STAGE(PG8_SB(0, 0), b2, voffB);
            PG8_BAR; PG8_WAIT_L(0); PG8_MMA(0, 1, At, B1); PG8_BAR;
            PG8_LDA(At, 0, 1); PG8_STAGE(PG8_SA(0, 0), a2, voffA);
            PG8_BAR; PG8_WAIT_L(0); PG8_MMA(1, 0, At, B0); PG8_BAR; PG8_SCHED;
            PG8_STAGE(PG8_SB(0, 1), b2 + hstep, voffB);
            PG8_WAIT_V(6); PG8_BAR; PG8_MMA(1, 1, At, B1); PG8_BAR;
            PG8_LDB(B0, 1, 0); PG8_SCHED; PG8_LDA(At, 1, 0); PG8_STAGE(PG8_SA(0, 1), a2 + hstep, voffA);
            PG8_WAIT_L(8); PG8_BAR; PG8_WAIT_L(0); PG8_MMA(0, 0, At, B0); PG8_BAR; PG8_SCHED;
            PG8_LDB(B1, 1, 1); PG8_STAGE(PG8_SB(1, 0), b3, voffB);
            PG8_BAR; PG8_WAIT_L(0); PG8_MMA(0, 1, At, B1); PG8_BAR;
            PG8_LDA(At, 1, 1); PG8_STAGE(PG8_SA(1, 0), a3, voffA);
            PG8_BAR; PG8_WAIT_L(0); PG8_MMA(1, 0, At, B0); PG8_BAR; PG8_SCHED;
            PG8_STAGE(PG8_SB(1, 1), b3 + hstep, voffB);
            PG8_WAIT_V(6); PG8_BAR; PG8_MMA(1, 1, At, B1); PG8_BAR;
        }
        { int fr2 = lane_id_(), fq2; fq2 = fr2 >> 4; fr2 &= 15; asm volatile("" : "+v"(fr2), "+v"(fq2)); E(acc, cur, wr, wc, fr2, fq2); }
        if (!has_next) break;
#pragma unroll
        for (int a = 0; a < 2; ++a)
#pragma unroll
            for (int b = 0; b < 2; ++b)
#pragma unroll
                for (int m = 0; m < 4; ++m)
#pragma unroll
                    for (int n = 0; n < 2; ++n) acc[a][b][m][n] = (f32x4){0.f, 0.f, 0.f, 0.f};
        cur = nxt; cA = nA; cB = nB; ++ui;
    }
    PG8_WAIT_V(0);
    if (wr == 0) PG8_BAR;
    PG8_BAR;
#undef PG8_SA
#undef PG8_SB
#undef PG8_STAGE
#undef PG8_LDA
#undef PG8_LDB
#undef PG8_MMA
#undef PG8_WAIT_V
#undef PG8_WAIT_L
#undef PG8_SCHED
}

struct EpiPlainBf16 {
    static constexpr bool PERM = true;
    bf16_t* O; int ldc; int frag = 0; int fmin = 8;
    __device__ __forceinline__ void operator()(f32x4 (&acc)[2][2][4][2], const Unit& u, int wr, int wc, int fr, int fq) const {
        bf16_t* base; size_t s_ai, s_m, s_bj;
        if (frag && u.pn >= fmin) { base = O + ((size_t)(u.pm * frag + u.pn) << 16) + (size_t)((((wr * 4 + wc) * 16) * 64 + fq * 16 + fr) << 3); s_ai = 4096; s_m = 1024; s_bj = 512; }
        else if (frag) { base = O + ((size_t)(u.pm * frag + u.pn) << 16) + (size_t)(((wr * 64 + fr) << 8) + wc * 32 + 8 * fq); s_ai = (size_t)HALF * 256; s_m = 16 * 256; s_bj = HALF; }
        else { base = O + (size_t)(u.pm * BM + wr * 64 + fr) * ldc + u.pn * BM + wc * 32 + 8 * fq; s_ai = (size_t)HALF * ldc; s_m = (size_t)16 * ldc; s_bj = HALF; }
#pragma unroll
        for (int ai = 0; ai < 2; ++ai)
#pragma unroll
            for (int m = 0; m < 4; ++m)
#pragma unroll
                for (int bj = 0; bj < 2; ++bj) { const f32x4 v0 = acc[ai][bj][m][0], v1 = acc[ai][bj][m][1];
                    u32x4 w; w.x = cvt_pk_bf16(v0[0], v0[1]); w.y = cvt_pk_bf16(v0[2], v0[3]); w.z = cvt_pk_bf16(v1[0], v1[1]); w.w = cvt_pk_bf16(v1[2], v1[3]);
                    *(u32x4*)(base + ai * s_ai + m * s_m + bj * s_bj) = w; }
    }
};
struct EpiDummy {
    static constexpr bool PERM = true;
    float* O;
    __device__ __forceinline__ void operator()(f32x4 (&acc)[2][2][4][2], const Unit& u, int wr, int wc, int fr, int fq) const {
        float s = 0.f;
#pragma unroll
        for (int ai = 0; ai < 2; ++ai)
#pragma unroll
            for (int bj = 0; bj < 2; ++bj)
#pragma unroll
                for (int m = 0; m < 4; ++m)
#pragma unroll
                    for (int n = 0; n < 2; ++n) s += (acc[ai][bj][m][n][0] + acc[ai][bj][m][n][1]) + (acc[ai][bj][m][n][2] + acc[ai][bj][m][n][3]);
        if (s == 12345.678f) O[u.pm * 256 + fr] = s;
    }
};
__device__ __forceinline__ float row_rstd(const float* ssq, int row, int fq) {
    const f32x4 a = *(const f32x4*)(ssq + (size_t)row * 32 + 8 * fq), b = *(const f32x4*)(ssq + (size_t)row * 32 + 8 * fq + 4);
    float t = ((a[0] + a[1]) + (a[2] + a[3])) + ((b[0] + b[1]) + (b[2] + b[3]));
    t += __shfl_xor(t, 16); t += __shfl_xor(t, 32);
    return rsqrtf(t * (1.0f / 2048.0f) + EPS);
}
template <bool RB>
struct EpiResid {
    static constexpr bool PERM = true;
    const void* res; bf16_t* outb; float* ssq;
    __device__ __forceinline__ void operator()(f32x4 (&acc)[2][2][4][2], const Unit& u, int wr, int wc, int fr, int fq) const {
        const int row0 = u.pm * BM + wr * 64 + fr, col0 = u.pn * BM + wc * 32 + 8 * fq;
        u32x4 rb[2][4][2];
        if (RB) {
#pragma unroll
            for (int ai = 0; ai < 2; ++ai)
#pragma unroll
                for (int m = 0; m < 4; ++m)
#pragma unroll
                    for (int bj = 0; bj < 2; ++bj) rb[ai][m][bj] = *(const u32x4*)((const bf16_t*)res + (size_t)(row0 + ai * HALF + m * 16) * DM + col0 + bj * HALF);
        }
#pragma unroll
        for (int ai = 0; ai < 2; ++ai) {
            f32x4 r[4][2][2];
#pragma unroll
            for (int m = 0; m < 4; ++m)
#pragma unroll
                for (int bj = 0; bj < 2; ++bj) { const size_t o = (size_t)(row0 + ai * HALF + m * 16) * DM + col0 + bj * HALF;
                    if (RB) { const u32x4 w = rb[ai][m][bj]; r[m][bj][0] = (f32x4){bflo(w.x), bfhi(w.x), bflo(w.y), bfhi(w.y)}; r[m][bj][1] = (f32x4){bflo(w.z), bfhi(w.z), bflo(w.w), bfhi(w.w)}; }
                    else { r[m][bj][0] = *(const f32x4*)((const float*)res + o); r[m][bj][1] = *(const f32x4*)((const float*)res + o + 4); } }
#pragma unroll
            for (int m = 0; m < 4; ++m) { const int row = row0 + ai * HALF + m * 16; const size_t off = (size_t)row * DM + col0; float s = 0.f;
#pragma unroll
                for (int bj = 0; bj < 2; ++bj) { const f32x4 v0 = acc[ai][bj][m][0] + r[m][bj][0], v1 = acc[ai][bj][m][1] + r[m][bj][1];
                    u32x4 w; w.x = cvt_pk_bf16(v0[0], v0[1]); w.y = cvt_pk_bf16(v0[2], v0[3]); w.z = cvt_pk_bf16(v1[0], v1[1]); w.w = cvt_pk_bf16(v1[2], v1[3]);
                    *(u32x4*)(outb + off + bj * HALF) = w;
                    s += ((v0[0] * v0[0] + v0[1] * v0[1]) + (v0[2] * v0[2] + v0[3] * v0[3])) + ((v1[0] * v1[0] + v1[1] * v1[1]) + (v1[2] * v1[2] + v1[3] * v1[3])); }
                s += __shfl_xor(s, 16); s += __shfl_xor(s, 32);
                if (fq == 0) ssq[(size_t)row * 32 + u.pn * 4 + wc] = s; }
            if (!RB) asm volatile("" ::: "memory"); }
    }
};
struct EpiPle {
    static constexpr bool PERM = true;
    const float* ssq_in; const bf16_t* pp; const bf16_t* hb; bf16_t* out; float* ssq;
    __device__ __forceinline__ void operator()(f32x4 (&acc)[2][2][4][2], const Unit& u, int wr, int wc, int fr, int fq) const {
        const int row0 = u.pm * BM + wr * 64 + fr, col0 = u.pn * BM + wc * 32 + 8 * fq;
        const bf16_t* ppf = pp + ((size_t)(u.pm * (DM / 256) + u.pn) << 16) + (size_t)((((wr * 4 + wc) * 16) * 64 + fq * 16 + fr) << 3);
#pragma unroll
        for (int ai = 0; ai < 2; ++ai) {
            u32x4 hw[4][2], pw[4][2]; float rstd[4];
#pragma unroll
            for (int m = 0; m < 4; ++m) { const int row = row0 + ai * HALF + m * 16;
#pragma unroll
                for (int bj = 0; bj < 2; ++bj) { const size_t o = (size_t)row * DM + col0 + bj * HALF; hw[m][bj] = *(const u32x4*)(hb + o); pw[m][bj] = *(const u32x4*)(ppf + (((ai * 4 + m) * 2 + bj) << 9)); }
                rstd[m] = row_rstd(ssq_in, row, fq); }
#pragma unroll
            for (int m = 0; m < 4; ++m) { const int row = row0 + ai * HALF + m * 16; const size_t off = (size_t)row * DM + col0; float s = 0.f;
#pragma unroll
                for (int bj = 0; bj < 2; ++bj) { const f32x4 z0 = acc[ai][bj][m][0] * rstd[m], z1 = acc[ai][bj][m][1] * rstd[m]; const u32x4 h2 = hw[m][bj], p2 = pw[m][bj]; f32x4 v0, v1;
                    v0[0] = bflo(h2.x) + sigmoidf_(z0[0]) * bflo(p2.x); v0[1] = bfhi(h2.x) + sigmoidf_(z0[1]) * bfhi(p2.x);
                    v0[2] = bflo(h2.y) + sigmoidf_(z0[2]) * bflo(p2.y); v0[3] = bfhi(h2.y) + sigmoidf_(z0[3]) * bfhi(p2.y);
                    v1[0] = bflo(h2.z) + sigmoidf_(z1[0]) * bflo(p2.z); v1[1] = bfhi(h2.z) + sigmoidf_(z1[1]) * bfhi(p2.z);
                    v1[2] = bflo(h2.w) + sigmoidf_(z1[2]) * bflo(p2.w); v1[3] = bfhi(h2.w) + sigmoidf_(z1[3]) * bfhi(p2.w);
                    u32x4 w; w.x = cvt_pk_bf16(v0[0], v0[1]); w.y = cvt_pk_bf16(v0[2], v0[3]); w.z = cvt_pk_bf16(v1[0], v1[1]); w.w = cvt_pk_bf16(v1[2], v1[3]);
                    *(u32x4*)(out + off + bj * HALF) = w;
                    s += ((v0[0] * v0[0] + v0[1] * v0[1]) + (v0[2] * v0[2] + v0[3] * v0[3])) + ((v1[0] * v1[0] + v1[1] * v1[1]) + (v1[2] * v1[2] + v1[3] * v1[3])); }
                s += __shfl_xor(s, 16); s += __shfl_xor(s, 32);
                if (fq == 0) ssq[(size_t)row * 32 + u.pn * 4 + wc] = s; }
            asm volatile("" ::: "memory"); }
    }
};
struct EpiConv {
    static constexpr bool PERM = false;
    const float* ssq_in; const float* cw; const float* cb; bf16_t* act; float* uedge; LAS float* ex; LAS float* cws; LAS float* rsl;
    __device__ __forceinline__ void conv_rows(const f32x4 curg, const f32x4 curv, f32x4 (&q1)[2], f32x4 (&q2)[2], const LAS float* cp, bf16_t* dst, const bool upd) const {
        f32x4 uc[2];
#pragma unroll
        for (int bj = 0; bj < 2; ++bj) {
            const f32x4 c0 = *(const LAS f32x4*)(cp + bj * 32), c1 = *(const LAS f32x4*)(cp + bj * 32 + 64), c2 = *(const LAS f32x4*)(cp + bj * 32 + 128), bb = *(const LAS f32x4*)(cp + bj * 32 + 192);
            const f32x4 cur = bj ? curv : curg;
#pragma unroll
            for (int e = 0; e < 4; ++e) {
                const float p1 = dpp_shr1(q1[bj][e], cur[e]), p2 = dpp_shr2(q2[bj][e], cur[e]);
                uc[bj][e] = bb[e] + c0[e] * p2 + c1[e] * p1 + c2[e] * cur[e];
                if (upd) { q1[bj][e] = dpp_ror1(cur[e]); q2[bj][e] = dpp_ror2(cur[e]); }
            }
        }
        u32x2 w;
        { const float a0 = uc[0][0] * sigmoidf_(uc[0][0]) * uc[1][0], a1 = uc[0][1] * sigmoidf_(uc[0][1]) * uc[1][1];
          const float a2 = uc[0][2] * sigmoidf_(uc[0][2]) * uc[1][2], a3 = uc[0][3] * sigmoidf_(uc[0][3]) * uc[1][3];
          w.x = cvt_pk_bf16(a0, a1); w.y = cvt_pk_bf16(a2, a3); }
        *(u32x2*)dst = w;
    }
    __device__ __forceinline__ void operator()(f32x4 (&acc)[2][2][4][2], const Unit& u, int wr, int wc, int fr, int fq) const {
        const int rowt = u.pm * BM + wr * 64 + fr, cl0 = wc * 32 + 4 * fq, wv = wr * 4 + wc, ln = fq * 16 + fr;
        float cwr[4];
#pragma unroll
        for (int i = 0; i < 4; ++i) { const float* srcp = (i < 3) ? (cw + (size_t)i * FF2) : cb; cwr[i] = srcp[(ln >> 5) * FF + u.pn * HALF + wc * 32 + (ln & 31)]; }
        {
            LAS float* myr = rsl + wv * 128; LAS int* mypm = (LAS int*)(rsl + 1024) + wv;
            if (__builtin_amdgcn_readfirstlane(*mypm) != u.pm) {
#pragma unroll
                for (int ai = 0; ai < 2; ++ai)
#pragma unroll
                    for (int m = 0; m < 4; ++m) { const float r_ = row_rstd(ssq_in, rowt + ai * HALF + m * 16, fq); if (fq == 0) myr[(ai * 4 + m) * 16 + fr] = r_; }
                if (fq == 0 && fr == 0) *mypm = u.pm;
                asm volatile("s_waitcnt lgkmcnt(0)" ::: "memory");
            }
#pragma unroll
            for (int ai = 0; ai < 2; ++ai)
#pragma unroll
                for (int m = 0; m < 4; ++m) { const float rstd = myr[(ai * 4 + m) * 16 + fr];
#pragma unroll
                    for (int bj = 0; bj < 2; ++bj)
#pragma unroll
                        for (int n = 0; n < 2; ++n) acc[ai][bj][m][n] *= rstd; }
        }
        if (fr >= 14) {
#pragma unroll
            for (int ai = 0; ai < 2; ++ai)
#pragma unroll
                for (int bj = 0; bj < 2; ++bj)
#pragma unroll
                    for (int n = 0; n < 2; ++n) *(LAS f32x4*)(ex + (((ai * 2 + wr) * 2 + (fr - 14)) * 256 + bj * HALF + cl0 + n * 16)) = acc[ai][bj][3][n];
        }
        if (wr == 0 && fr < 2) {
#pragma unroll
            for (int bj = 0; bj < 2; ++bj)
#pragma unroll
                for (int n = 0; n < 2; ++n) *(f32x4*)(uedge + ((size_t)(u.pm * 4 + fr) * FF2 + u.pn * BM + bj * HALF + cl0 + n * 16)) = acc[0][bj][0][n];
        }
        if (wr == 1 && fr >= 14) {
#pragma unroll
            for (int bj = 0; bj < 2; ++bj)
#pragma unroll
                for (int n = 0; n < 2; ++n) *(f32x4*)(uedge + ((size_t)(u.pm * 4 + 2 + (fr - 14)) * FF2 + u.pn * BM + bj * HALF + cl0 + n * 16)) = acc[1][bj][3][n];
        }
        LAS float* myc = cws + wv * 256;
#pragma unroll
        for (int i = 0; i < 4; ++i) myc[i * 64 + ln] = cwr[i];
        asm volatile("s_waitcnt lgkmcnt(0)" ::: "memory");
#pragma unroll
        for (int n = 0; n < 2; ++n) {
            const int jcol = u.pn * HALF + cl0 + n * 16; const LAS float* cp = myc + 16 * n + 4 * fq;
#pragma unroll
            for (int ai = 0; ai < 2; ++ai) {
                f32x4 q1[2], q2[2];
#pragma unroll
                for (int bj = 0; bj < 2; ++bj)
#pragma unroll
                    for (int e = 0; e < 4; ++e) { q1[bj][e] = dpp_ror1(acc[ai][bj][0][n][e]); q2[bj][e] = dpp_ror2(acc[ai][bj][0][n][e]); }
#pragma unroll
                for (int m = 1; m < 4; ++m) conv_rows(acc[ai][0][m][n], acc[ai][1][m][n], q1, q2, cp, act + (size_t)(rowt + ai * HALF + m * 16) * FF + jcol, m < 3);
            }
        }
        asm volatile("s_waitcnt lgkmcnt(0)" ::: "memory"); PG8_BAR; PG8_BAR; asm volatile("" ::: "memory");
#pragma unroll
        for (int n = 0; n < 2; ++n) {
            const int jcol = u.pn * HALF + cl0 + n * 16; const LAS float* cp = myc + 16 * n + 4 * fq;
#pragma unroll
            for (int ai = 0; ai < 2; ++ai) {
                const bool has_prev = !(ai == 0 && wr == 0);
                const int slot = (wr == 1) ? (ai * 2) : ((ai - 1) * 2 + 1);
                f32x4 q1[2], q2[2];
#pragma unroll
                for (int bj = 0; bj < 2; ++bj) {
                    f32x4 e0 = (f32x4){0.f, 0.f, 0.f, 0.f}, e1 = (f32x4){0.f, 0.f, 0.f, 0.f};
                    if (has_prev) { e0 = *(const LAS f32x4*)(ex + ((slot * 2 + 0) * 256 + bj * HALF + cl0 + n * 16)); e1 = *(const LAS f32x4*)(ex + ((slot * 2 + 1) * 256 + bj * HALF + cl0 + n * 16)); }
                    q1[bj] = e1;
#pragma unroll
                    for (int e = 0; e < 4; ++e) q2[bj][e] = (fr == 1) ? e1[e] : e0[e];
                }
                conv_rows(acc[ai][0][0][n], acc[ai][1][0][n], q1, q2, cp, act + (size_t)(rowt + ai * HALF) * FF + jcol, false);
            }
        }
    }
};
#undef PG8_BAR
}

__device__ void phase0(const Params& p, LAS unsigned char* lds, const int WID) {
    unsigned char* ws = p.ws;
    const int G = gridDim.x, bx = blockIdx.x, wid = WID, lane = lane_id_(), tid = wid * 64 + lane;
    { const float* x = p.in[0]; const float* gm = p.in[2]; bf16_t* xa = (bf16_t*)(ws + WS_XA);
      for (int r = bx * 8 + wid; r < MTOK; r += G * 8) { const float* xr = x + (size_t)r * DM; f32x4 v[8]; float s = 0.f;
#pragma unroll
          for (int i = 0; i < 8; ++i) { v[i] = *(const f32x4*)(xr + i * 256 + lane * 4); s += (v[i][0] * v[i][0] + v[i][1] * v[i][1]) + (v[i][2] * v[i][2] + v[i][3] * v[i][3]); }
#pragma unroll
          for (int o = 32; o >= 1; o >>= 1) s += __shfl_xor(s, o);
          const float rstd = rsqrtf(s * (1.0f / 2048.0f) + EPS);
#pragma unroll
          for (int i = 0; i < 8; ++i) { const f32x4 gv = *(const f32x4*)(gm + i * 256 + lane * 4); u32x2 w; w.x = cvt_pk_bf16(v[i][0] * rstd * gv[0], v[i][1] * rstd * gv[1]); w.y = cvt_pk_bf16(v[i][2] * rstd * gv[2], v[i][3] * rstd * gv[3]);
              *(u32x2*)(xa + (size_t)r * DM + i * 256 + lane * 4) = w; } } }
    { const float* pin = p.in[1]; bf16_t* pb = (bf16_t*)(ws + WS_PB);
      for (int i = bx * 512 + tid; i < MTOK * PLE / 4; i += G * 512) { const f32x4 v = *(const f32x4*)(pin + (size_t)i * 4); u32x2 w; w.x = cvt_pk_bf16(v[0], v[1]); w.y = cvt_pk_bf16(v[2], v[3]); *(u32x2*)(pb + (size_t)i * 4) = w; } }
    constexpr int J0 = 16 * 112, J1 = J0 + 16 * 32, J2 = J1 + 16 * 176, J3 = J2 + 44 * 32, J4 = J3 + 16 * 32, J5 = J4 + 2 * 32;
    const float* src = nullptr; bf16_t* dst = nullptr; const float* scale = nullptr; int K = 0, N = 0, mode = 0, k0 = 0, n0 = 0;
#define P0_DECODE(job) do { int tp_; \
        if ((job) < J0) { src = p.in[3]; dst = (bf16_t*)(ws + WS_WIN); scale = nullptr; K = DM; N = INC; mode = 0; tp_ = (job); } \
        else if ((job) < J1) { src = p.in[7]; dst = (bf16_t*)(ws + WS_WOUT); scale = nullptr; K = DM; N = DM; mode = 0; tp_ = (job) - J0; } \
        else if ((job) < J2) { src = p.in[9]; dst = (bf16_t*)(ws + WS_WUP); scale = p.in[8]; K = DM; N = FF2; mode = 1; tp_ = (job) - J1; } \
        else if ((job) < J3) { src = p.in[12]; dst = (bf16_t*)(ws + WS_WDOWN); scale = nullptr; K = FF; N = DM; mode = 0; tp_ = (job) - J2; } \
        else if ((job) < J4) { src = p.in[14]; dst = (bf16_t*)(ws + WS_WGATE); scale = p.in[13]; K = DM; N = DM; mode = 0; tp_ = (job) - J3; } \
        else { src = p.in[15]; dst = (bf16_t*)(ws + WS_WPROJ); scale = nullptr; K = PLE; N = DM; mode = 0; tp_ = (job) - J4; } \
        const int nk2_ = K >> 7; k0 = (tp_ % nk2_) * 128; n0 = (tp_ / nk2_) * 64; } while (0)
#define P0_LOAD() do { _Pragma("unroll") for (int i_ = 0; i_ < 4; ++i_) { const int kk_ = (tid >> 4) + 32 * i_; \
        v[i_] = *(const f32x4*)(src + (size_t)(k0 + kk_) * N + n0 + (tid & 15) * 4); sc[i_] = scale ? scale[k0 + kk_] : 1.0f; } } while (0)
    f32x4 v[4]; float sc[4];
    int job = bx, buf = 0;
    if (job < J5) { P0_DECODE(job); P0_LOAD(); }
    __syncthreads();
    while (job < J5) {
        LAS bf16_t* tl = (LAS bf16_t*)(lds + buf * 17408);
        const int nn = (tid & 15) * 4;
#pragma unroll
        for (int i = 0; i < 4; ++i) { const int kk = (tid >> 4) + 32 * i; const unsigned w0 = cvt_pk_bf16(v[i][0] * sc[i], v[i][1] * sc[i]), w1 = cvt_pk_bf16(v[i][2] * sc[i], v[i][3] * sc[i]);
            tl[(nn + 0) * 136 + kk] = (bf16_t)(w0 & 0xffff); tl[(nn + 1) * 136 + kk] = (bf16_t)(w0 >> 16); tl[(nn + 2) * 136 + kk] = (bf16_t)(w1 & 0xffff); tl[(nn + 3) * 136 + kk] = (bf16_t)(w1 >> 16); }
        bf16_t* cdst = dst; const int cK = K, cmode = mode, ck0 = k0, cn0 = n0;
        const int nxt = job + G;
        if (nxt < J5) { P0_DECODE(nxt); P0_LOAD(); }
        __syncthreads();
        { const int n = tid >> 3, kc = (tid & 7) * 16; const LAS unsigned char* rp = lds + buf * 17408 + n * 272 + kc * 2;
          const u32x4 w0 = *(const LAS u32x4*)rp, w1 = *(const LAS u32x4*)(rp + 16);
          int R = cn0 + n;
          if (cmode == 1) { const int j = (R < FF) ? R : R - FF; R = 256 * (j >> 7) + (j & 127) + ((cn0 + n < FF) ? 0 : 128); }
          bf16_t* op = cdst + (size_t)R * cK + ck0 + kc; *(u32x4*)op = w0; *(u32x4*)(op + 8) = w1; }
        job = nxt; buf ^= 1;
    }
#undef P0_DECODE
#undef P0_LOAD
    __syncthreads();
}

__device__ __forceinline__ void attn_softmax(f32x4 (&sc)[4], float& m_run, float& l_run, f32x4 (&o)[8], const int j, const int tq, const int g, const LAS float* tb, bf16x8 (&pb)[2]) {
    const float SC = 0.08838834764831845f * LOG2E;
    float mx = m_run;
    if (j <= 5) { const float bc = tb[256];
#pragma unroll
        for (int mt = 0; mt < 4; ++mt)
#pragma unroll
            for (int e = 0; e < 4; ++e) { sc[mt][e] = sc[mt][e] * SC + bc; mx = fmaxf(mx, sc[mt][e]); } }
    else { const int relb = tq + 64 * (8 - j) - 4 * g;
#pragma unroll
        for (int mt = 0; mt < 4; ++mt)
#pragma unroll
            for (int e = 0; e < 4; ++e) { int rel = relb - 16 * mt - e; rel = rel > 128 ? 128 : rel; sc[mt][e] = sc[mt][e] * SC + tb[rel + 128]; mx = fmaxf(mx, sc[mt][e]); } }
    mx = fmaxf(mx, __shfl_xor(mx, 16)); mx = fmaxf(mx, __shfl_xor(mx, 32));
    const float alpha = __builtin_amdgcn_exp2f(m_run - mx); m_run = mx;
    float ls = 0.f;
#pragma unroll
    for (int mt = 0; mt < 4; ++mt)
#pragma unroll
        for (int e = 0; e < 4; ++e) { sc[mt][e] = __builtin_amdgcn_exp2f(sc[mt][e] - mx); ls += sc[mt][e]; }
    l_run = l_run * alpha + ls;
    if (__builtin_amdgcn_ballot_w64(alpha != 1.0f) != 0ull) {
#pragma unroll
        for (int cc = 0; cc < 8; ++cc) o[cc] *= alpha;
    }
#pragma unroll
    for (int s2 = 0; s2 < 2; ++s2) { u32x4 pw; pw.x = cvt_pk_bf16(sc[2 * s2][0], sc[2 * s2][1]); pw.y = cvt_pk_bf16(sc[2 * s2][2], sc[2 * s2][3]);
        pw.z = cvt_pk_bf16(sc[2 * s2 + 1][0], sc[2 * s2 + 1][1]); pw.w = cvt_pk_bf16(sc[2 * s2 + 1][2], sc[2 * s2 + 1][3]); pb[s2] = __builtin_bit_cast(bf16x8, pw); }
}
__device__ void attn_quad(const bf16_t* proj, const float* rel_bias, bf16_t* ycat, int quad, LAS unsigned char* lds, const int WID) {
    const int tid = TID_X, grp = WID >> 2, wq = WID & 3, lane = tid & 63, g = lane >> 4, li = lane & 15;
    const int bh = quad >> 4, c0 = (quad & 15) * 4, h = bh & 7, b = bh >> 3;
    const int kA = 2 * grp, kB = kA + 1;
    const int tokq = b * SEQ + c0 * 64;
    LAS float* tb = (LAS float*)(lds + 65536);
    __syncthreads();
    for (int i = tid; i < 257; i += 512) tb[i] = rel_bias[h * 257 + i] * LOG2E;
    bf16x8 qfA[4], qfB[4];
    { const int qr = tokq + kA * 64 + 16 * wq + li, qc = 4096 + 128 * h + 8 * g;
#pragma unroll
      for (int ks = 0; ks < 4; ++ks) { qfA[ks] = *(const bf16x8*)(proj + proj_off_fr(qr, qc + 32 * ks)); qfB[ks] = *(const bf16x8*)(proj + proj_off_fr(qr + 64, qc + 32 * ks)); } }
    float mA = -1e30f, lA = 0.f, mB = -1e30f, lB = 0.f; f32x4 oA[8], oB[8];
#pragma unroll
    for (int cc = 0; cc < 8; ++cc) { oA[cc] = (f32x4){0.f, 0.f, 0.f, 0.f}; oB[cc] = (f32x4){0.f, 0.f, 0.f, 0.f}; }
    const int u0 = (8 - c0) > 0 ? (8 - c0) : 0;
    const int srow = 16 * (WID & 3) + (tid & 15), sch = 4 * (WID >> 2) + ((tid >> 4) & 3);
    u32x4 kr0[2], vr0[2], kr1[2], vr1[2];
    const bf16_t* kb0 = proj + proj_off_fr(tokq - 512 + srow, 5120 + 128 * h + 8 * sch); const bf16_t* vb0 = proj + proj_off_fr(tokq - 512 + srow, 6144 + 128 * h + 8 * sch);
#define ATT_LOAD(u_, KR, VR) do { const long _o = (long)((u_) >> 2) * (28L << 16) + ((u_) & 1) * 32768 + (((u_) >> 1) & 1) * 4096; _Pragma("unroll") for (int _i = 0; _i < 2; ++_i) { \
        KR[_i] = *(const u32x4*)(kb0 + _o + _i * 16384); VR[_i] = *(const u32x4*)(vb0 + _o + _i * 16384); } } while (0)
#define ATT_STORE(buf_, KR, VR) do { _Pragma("unroll") for (int _i = 0; _i < 2; ++_i) { const unsigned ob_ = off_b(srow, sch + 8 * _i); \
        *(LAS u32x4*)(lds + (buf_) * 32768 + ob_) = KR[_i]; *(LAS u32x4*)(lds + (buf_) * 32768 + 16384 + ob_) = VR[_i]; } } while (0)
    const int tq = 16 * wq + li;
    const unsigned trq = (unsigned)(li >> 2), trp = (unsigned)(li & 3);
#define ATT_COMPUTE(u) do { \
        LAS unsigned char* Kimg = lds + buf * 32768; LAS unsigned char* Vimg = Kimg + 16384; \
        const bool actA = ((u) >= kA) && ((u) <= kA + 8), actB = ((u) >= kB) && ((u) <= kB + 8); \
        if (actA || actB) { \
            f32x4 sA[4], sB[4]; \
            _Pragma("unroll") for (int mt = 0; mt < 4; ++mt) { sA[mt] = (f32x4){0.f, 0.f, 0.f, 0.f}; sB[mt] = (f32x4){0.f, 0.f, 0.f, 0.f}; \
                _Pragma("unroll") for (int ks = 0; ks < 4; ++ks) { const bf16x8 a = *(const LAS bf16x8*)(Kimg + off_b(16 * mt + li, 4 * ks + g)); \
                    if (actA) sA[mt] = __builtin_amdgcn_mfma_f32_16x16x32_bf16(a, qfA[ks], sA[mt], 0, 0, 0); \
                    if (actB) sB[mt] = __builtin_amdgcn_mfma_f32_16x16x32_bf16(a, qfB[ks], sB[mt], 0, 0, 0); } } \
            bf16x8 pbA[2], pbB[2]; \
            pbA[0] = pbA[1] = pbB[0] = pbB[1] = (bf16x8){0, 0, 0, 0, 0, 0, 0, 0}; \
            if (actA) attn_softmax(sA, mA, lA, oA, (u) - kA, tq, g, tb, pbA); \
            if (actB) attn_softmax(sB, mB, lB, oB, (u) - kB, tq, g, tb, pbB); \
            _Pragma("unroll") for (int s2 = 0; s2 < 2; ++s2) { const unsigned r0 = 32 * s2 + 4 * g + trq, r1 = r0 + 16; \
                _Pragma("unroll") for (int cc = 0; cc < 8; ++cc) { \
                    const s16x4 lo = tr_read(Vimg + off_b(r0, 2 * cc + (trp >> 1)) + 8 * (trp & 1)), hi = tr_read(Vimg + off_b(r1, 2 * cc + (trp >> 1)) + 8 * (trp & 1)); \
                    const bf16x8 vf = cat8(lo, hi); \
                    if (actA) oA[cc] = __builtin_amdgcn_mfma_f32_16x16x32_bf16(vf, pbA[s2], oA[cc], 0, 0, 0); \
                    if (actB) oB[cc] = __builtin_amdgcn_mfma_f32_16x16x32_bf16(vf, pbB[s2], oB[cc], 0, 0, 0); \
                } } \
        } } while (0)
    ATT_LOAD(u0, kr0, vr0); ATT_LOAD(u0 + 1, kr1, vr1); ATT_STORE(0, kr0, vr0);
    __syncthreads();
    int buf = 0;
    for (int u = u0; u < 12; u += 2) {
        if (u + 2 < 12) ATT_LOAD(u + 2, kr0, vr0);
        ATT_COMPUTE(u);
        ATT_STORE(buf ^ 1, kr1, vr1);
        __syncthreads(); buf ^= 1;
        if (u + 3 < 12) ATT_LOAD(u + 3, kr1, vr1);
        ATT_COMPUTE(u + 1);
        if (u + 2 < 12) ATT_STORE(buf ^ 1, kr0, vr0);
        __syncthreads(); buf ^= 1;
    }
#undef ATT_COMPUTE
#undef ATT_LOAD
#undef ATT_STORE
    lA += __shfl_xor(lA, 16); lA += __shfl_xor(lA, 32); lB += __shfl_xor(lB, 16); lB += __shfl_xor(lB, 32);
    const float invA = 1.0f / lA, invB = 1.0f / lB;
    bf16_t* yp = ycat + (size_t)(tokq + kA * 64 + tq) * DM + 1024 + 128 * h + 4 * g;
#pragma unroll
    for (int cc = 0; cc < 8; ++cc) { u32x2 w; w.x = cvt_pk_bf16(oA[cc][0] * invA, oA[cc][1] * invA); w.y = cvt_pk_bf16(oA[cc][2] * invA, oA[cc][3] * invA); *(u32x2*)(yp + 16 * cc) = w;
        u32x2 w2; w2.x = cvt_pk_bf16(oB[cc][0] * invB, oB[cc][1] * invB); w2.y = cvt_pk_bf16(oB[cc][2] * invB, oB[cc][3] * invB); *(u32x2*)(yp + (size_t)64 * DM + 16 * cc) = w2; }
}

constexpr int HG_K = 0, HG_V = 16384, HG_Q1 = 32768, HG_Q2 = 49152, HG_S = 65536, HG_TOT = 98304, HG_RED = 102400;

__device__ void hgrn_state_loop(const bf16_t* proj, const float* lbl, float* ust, float* ddec, int task, const int stride, const int ntask, LAS unsigned char* lds, const int WID) {
    const int wid = WID, lane = lane_id_(), tid = wid * 64 + lane, g = lane >> 4, li = lane & 15;
    const int dp = tid & 63, sq = tid >> 6, d0 = 2 * dp;
    LAS float* tot = (LAS float*)(lds + HG_TOT);
    const unsigned trq = (unsigned)(li >> 2), trp = (unsigned)(li & 3);
    const int vrow = 16 * (wid & 3) + li, vch = 4 * (wid >> 2) + g;
    unsigned fw[8]; u32x4 vr[2]; float lbv[4];
#define H1_LOAD(task_) do { const int c_ = (task_) & 63, bh_ = (task_) >> 6, h_ = bh_ & 7, b_ = bh_ >> 3; const int tok_ = b_ * SEQ + c_ * 64; \
        lbv[0] = lbl[128 * h_ + d0]; lbv[1] = lbl[128 * h_ + d0 + 1]; lbv[2] = lbl[1024 + 128 * h_ + d0]; lbv[3] = lbl[1024 + 128 * h_ + d0 + 1]; \
        { const bf16_t* fb_ = proj + proj_off_rm(tok_ + 8 * sq, 1024 + 128 * h_ + d0); _Pragma("unroll") for (int i_ = 0; i_ < 8; ++i_) fw[i_] = *(const unsigned*)(fb_ + i_ * 256); } \
        { const bf16_t* vb_ = proj + proj_off_fr(tok_ + vrow, 2048 + 128 * h_ + 8 * vch); _Pragma("unroll") for (int i_ = 0; i_ < 2; ++i_) vr[i_] = *(const u32x4*)(vb_ + i_ * 16384); } } while (0)
    if (task < ntask) H1_LOAD(task);
    while (task < ntask) {
        const int c = task & 63, bh = task >> 6;
        const int ci = bh * 64 + c;
        __syncthreads();
        float lb[2];
        lb[0] = __builtin_amdgcn_rcpf(1.0f + __expf(lbv[2] - lbv[0])); lb[1] = __builtin_amdgcn_rcpf(1.0f + __expf(lbv[3] - lbv[1]));
        float cs[8][2], kg[8][2];
        { float run0 = 0.f, run1 = 0.f;
#pragma unroll
          for (int i = 0; i < 8; ++i) { const unsigned w = fw[i];
              const float s0 = sigmoidf_(bflo(w)), s1 = sigmoidf_(bfhi(w));
              run0 += __logf(lb[0] + (1.0f - lb[0]) * s0); run1 += __logf(lb[1] + (1.0f - lb[1]) * s1);
              cs[i][0] = run0; cs[i][1] = run1; kg[i][0] = (1.0f - lb[0]) * (1.0f - s0); kg[i][1] = (1.0f - lb[1]) * (1.0f - s1); }
          tot[sq * 128 + d0] = run0; tot[sq * 128 + d0 + 1] = run1; }
#pragma unroll
        for (int i = 0; i < 2; ++i) *(LAS u32x4*)(lds + HG_V + off_b(vrow, vch + 8 * i)) = vr[i];
        const int nxt = task + stride;
        if (nxt < ntask) H1_LOAD(nxt);
        __syncthreads();
        float pre0 = 0.f, pre1 = 0.f, bl0 = 0.f, bl1 = 0.f;
#pragma unroll
        for (int q = 0; q < 8; ++q) { const float t0 = tot[q * 128 + d0], t1 = tot[q * 128 + d0 + 1]; if (q < sq) { pre0 += t0; pre1 += t1; } bl0 += t0; bl1 += t1; }
#pragma unroll
        for (int i = 0; i < 8; ++i) { const int s_ = 8 * sq + i; const float k0 = kg[i][0] * __expf(bl0 - (pre0 + cs[i][0])), k1 = kg[i][1] * __expf(bl1 - (pre1 + cs[i][1]));
            *(LAS unsigned*)(lds + HG_K + off_b(s_, dp >> 2) + (dp & 3) * 4) = cvt_pk_bf16(k0, k1); }
        if (sq == 0) { f32x2 dv; dv.x = __expf(bl0); dv.y = __expf(bl1); *(f32x2*)(ddec + (size_t)ci * 128 + d0) = dv; }
        __syncthreads();
        f32x4 acc[8];
#pragma unroll
        for (int nt = 0; nt < 8; ++nt) acc[nt] = (f32x4){0.f, 0.f, 0.f, 0.f};
#pragma unroll
        for (int ks = 0; ks < 2; ++ks) {
            const unsigned r0 = 32 * ks + 8 * g + trq, r1 = r0 + 4;
            const bf16x8 a = cat8(tr_read(lds + HG_K + off_b(r0, 2 * wid + (trp >> 1)) + 8 * (trp & 1)), tr_read(lds + HG_K + off_b(r1, 2 * wid + (trp >> 1)) + 8 * (trp & 1)));
#pragma unroll
            for (int nt = 0; nt < 8; ++nt) {
                const bf16x8 bb = cat8(tr_read(lds + HG_V + off_b(r0, 2 * nt + (trp >> 1)) + 8 * (trp & 1)), tr_read(lds + HG_V + off_b(r1, 2 * nt + (trp >> 1)) + 8 * (trp & 1)));
                acc[nt] = __builtin_amdgcn_mfma_f32_16x16x32_bf16(a, bb, acc[nt], 0, 0, 0);
            }
        }
        bf16_t* up = (bf16_t*)ust + (size_t)ci * 16384 + 16 * wid + 4 * g;
#pragma unroll
        for (int nt = 0; nt < 8; ++nt) { u32x2 w; w.x = cvt_pk_bf16(acc[nt][0], acc[nt][1]); w.y = cvt_pk_bf16(acc[nt][2], acc[nt][3]); *(u32x2*)(up + (size_t)(16 * nt + li) * 128) = w; }
        task = nxt;
    }
#undef H1_LOAD
}

__device__ void hgrn_scan(const float* ust, const float* ddec, bf16_t* sst, const int WID) {
    for (int e4 = blockIdx.x * 512 + TID_X; e4 < 32 * 4096; e4 += gridDim.x * 512) {
        const int bh = e4 >> 12, off = (e4 & 4095) * 4, d = off & 127;
        f32x4 S = (f32x4){0.f, 0.f, 0.f, 0.f};
        const bf16_t* up = (const bf16_t*)ust + (size_t)bh * 64 * 16384 + off; const float* dp = ddec + (size_t)bh * 64 * 128 + d; bf16_t* sp = sst + (size_t)bh * 64 * 16384 + off;
#pragma unroll 16
        for (int c = 0; c < 64; ++c) {
            const u32x2 uw = *(const u32x2*)(up + (size_t)c * 16384); const f32x4 U = (f32x4){bflo(uw.x), bfhi(uw.x), bflo(uw.y), bfhi(uw.y)}; const f32x4 Dv = *(const f32x4*)(dp + c * 128);
            u32x2 w; w.x = cvt_pk_bf16(S[0], S[1]); w.y = cvt_pk_bf16(S[2], S[3]); *(u32x2*)(sp + (size_t)c * 16384) = w;
            S = Dv * S + U;
        }
    }
}

__device__ void hgrn_out_loop(const bf16_t* proj, const float* lbl, const bf16_t* sst, const float* hgn, bf16_t* ycat, int task, const int stride, const int ntask, LAS unsigned char* lds, const int WID) {
    const int wid = WID, lane = lane_id_(), tid = wid * 64 + lane, g = lane >> 4, li = lane & 15;
    const int dp = tid & 63, sq = tid >> 6, d0 = 2 * dp;
    const int nt = wid & 3, vh = wid >> 2, tloc = 16 * nt + li;
    LAS float* tot = (LAS float*)(lds + HG_TOT);
    LAS float* red = (LAS float*)(lds + HG_RED);
    const unsigned trq = (unsigned)(li >> 2), trp = (unsigned)(li & 3);
    const int vrow = 16 * (wid & 3) + li, vch = 4 * (wid >> 2) + g;
    f32x4 nv[4];
#pragma unroll
    for (int vt = 0; vt < 4; ++vt) nv[vt] = *(const f32x4*)(hgn + 16 * (4 * vh + vt) + 4 * g);
    unsigned fw[8], qw[8]; u32x4 vr[2], sr[4]; u32x2 gw[4], gwn[4]; float lbv[4];
#define H3_LOAD(task_, GW) do { const int c_ = (task_) & 63, bh_ = (task_) >> 6, h_ = bh_ & 7, b_ = bh_ >> 3; const int tok_ = b_ * SEQ + c_ * 64; const size_t ci_ = (size_t)(bh_ * 64 + c_); \
        lbv[0] = lbl[128 * h_ + d0]; lbv[1] = lbl[128 * h_ + d0 + 1]; lbv[2] = lbl[1024 + 128 * h_ + d0]; lbv[3] = lbl[1024 + 128 * h_ + d0 + 1]; \
        { const bf16_t* qb_ = proj + proj_off_rm(tok_ + 8 * sq, 128 * h_ + d0); _Pragma("unroll") for (int i_ = 0; i_ < 8; ++i_) { fw[i_] = *(const unsigned*)(qb_ + (4L << 16) + i_ * 256); qw[i_] = *(const unsigned*)(qb_ + i_ * 256); } } \
        { const bf16_t* vb_ = proj + proj_off_fr(tok_ + vrow, 2048 + 128 * h_ + 8 * vch); _Pragma("unroll") for (int i_ = 0; i_ < 2; ++i_) vr[i_] = *(const u32x4*)(vb_ + i_ * 16384); } \
        _Pragma("unroll") for (int i_ = 0; i_ < 4; ++i_) { const int n_ = tid + 512 * i_; sr[i_] = *(const u32x4*)(sst + ci_ * 16384 + (n_ >> 4) * 128 + 8 * (n_ & 15)); } \
        { const bf16_t* gb_ = proj + proj_off_fr(tok_ + tloc, 3072 + 128 * h_ + 4 * g + 64 * vh); _Pragma("unroll") for (int vt_ = 0; vt_ < 4; ++vt_) GW[vt_] = *(const u32x2*)(gb_ + (vt_ & 1) * 256 + (vt_ >> 1) * 8192); } } while (0)
    if (task < ntask) H3_LOAD(task, gw);
    while (task < ntask) {
        const int c = task & 63, bh = task >> 6, h = bh & 7, b = bh >> 3;
        const int tok0 = b * SEQ + c * 64;
        __syncthreads();
        float lb[2];
        lb[0] = __builtin_amdgcn_rcpf(1.0f + __expf(lbv[2] - lbv[0])); lb[1] = __builtin_amdgcn_rcpf(1.0f + __expf(lbv[3] - lbv[1]));
        float cs[8][2], kg[8][2], qs[8][2];
        { float run0 = 0.f, run1 = 0.f;
#pragma unroll
          for (int i = 0; i < 8; ++i) { const unsigned w = fw[i], wq_ = qw[i];
              const float s0 = sigmoidf_(bflo(w)), s1 = sigmoidf_(bfhi(w));
              run0 += __logf(lb[0] + (1.0f - lb[0]) * s0); run1 += __logf(lb[1] + (1.0f - lb[1]) * s1);
              cs[i][0] = run0; cs[i][1] = run1; kg[i][0] = (1.0f - lb[0]) * (1.0f - s0); kg[i][1] = (1.0f - lb[1]) * (1.0f - s1);
              const float q0 = bflo(wq_), q1 = bfhi(wq_); qs[i][0] = q0 * sigmoidf_(q0); qs[i][1] = q1 * sigmoidf_(q1); }
          tot[sq * 128 + d0] = run0; tot[sq * 128 + d0 + 1] = run1; }
#pragma unroll
        for (int i = 0; i < 2; ++i) *(LAS u32x4*)(lds + HG_V + off_b(vrow, vch + 8 * i)) = vr[i];
#pragma unroll
        for (int i = 0; i < 4; ++i) { const int n = tid + 512 * i; *(LAS u32x4*)(lds + HG_S + off_b(n >> 4, n & 15)) = sr[i]; }
        __syncthreads();
        { float pre0 = 0.f, pre1 = 0.f, bm0 = 0.f, bm1 = 0.f;
#pragma unroll
          for (int q = 0; q < 8; ++q) { const float t0 = tot[q * 128 + d0], t1 = tot[q * 128 + d0 + 1]; if (q < sq) { pre0 += t0; pre1 += t1; } if (q < 4) { bm0 += t0; bm1 += t1; } }
#pragma unroll
          for (int i = 0; i < 8; ++i) { const int s_ = 8 * sq + i; const float b0 = pre0 + cs[i][0], b1 = pre1 + cs[i][1];
              const unsigned o_ = off_b(s_, dp >> 2) + (dp & 3) * 4;
              *(LAS unsigned*)(lds + HG_K + o_) = cvt_pk_bf16(kg[i][0] * __expf(bm0 - b0), kg[i][1] * __expf(bm1 - b1));
              *(LAS unsigned*)(lds + HG_Q1 + o_) = cvt_pk_bf16(qs[i][0] * __expf(b0 - bm0), qs[i][1] * __expf(b1 - bm1));
              *(LAS unsigned*)(lds + HG_Q2 + o_) = cvt_pk_bf16(qs[i][0] * __expf(b0), qs[i][1] * __expf(b1)); } }
        const int nxt = task + stride;
        if (nxt < ntask) H3_LOAD(nxt, gwn);
        __syncthreads();
        bf16x8 q1f[4], q2f[4];
#pragma unroll
        for (int ks = 0; ks < 4; ++ks) { q1f[ks] = *(const LAS bf16x8*)(lds + HG_Q1 + off_b(16 * nt + li, 4 * ks + g)); q2f[ks] = *(const LAS bf16x8*)(lds + HG_Q2 + off_b(16 * nt + li, 4 * ks + g)); }
        f32x4 sc[4];
#pragma unroll
        for (int mt = 0; mt < 4; ++mt) { sc[mt] = (f32x4){0.f, 0.f, 0.f, 0.f};
            if (mt <= nt) {
#pragma unroll
                for (int ks = 0; ks < 4; ++ks) { const bf16x8 a = *(const LAS bf16x8*)(lds + HG_K + off_b(16 * mt + li, 4 * ks + g)); sc[mt] = __builtin_amdgcn_mfma_f32_16x16x32_bf16(a, q1f[ks], sc[mt], 0, 0, 0); }
#pragma unroll
                for (int e = 0; e < 4; ++e) { const int s_ = 16 * mt + 4 * g + e; sc[mt][e] = (s_ <= tloc) ? sc[mt][e] : 0.f; }
            } }
        bf16x8 pb[2];
#pragma unroll
        for (int s2 = 0; s2 < 2; ++s2) { u32x4 pw; pw.x = cvt_pk_bf16(sc[2 * s2][0], sc[2 * s2][1]); pw.y = cvt_pk_bf16(sc[2 * s2][2], sc[2 * s2][3]);
            pw.z = cvt_pk_bf16(sc[2 * s2 + 1][0], sc[2 * s2 + 1][1]); pw.w = cvt_pk_bf16(sc[2 * s2 + 1][2], sc[2 * s2 + 1][3]); pb[s2] = __builtin_bit_cast(bf16x8, pw); }
        f32x4 o[4];
#pragma unroll
        for (int vt = 0; vt < 4; ++vt) { o[vt] = (f32x4){0.f, 0.f, 0.f, 0.f}; const int vtile = 4 * vh + vt;
#pragma unroll
            for (int ks = 0; ks < 4; ++ks) { const bf16x8 a = *(const LAS bf16x8*)(lds + HG_S + off_b(16 * vtile + li, 4 * ks + g)); o[vt] = __builtin_amdgcn_mfma_f32_16x16x32_bf16(a, q2f[ks], o[vt], 0, 0, 0); }
#pragma unroll
            for (int s2 = 0; s2 < 2; ++s2) { const unsigned r0 = 32 * s2 + 4 * g + trq, r1 = r0 + 16;
                const bf16x8 a = cat8(tr_read(lds + HG_V + off_b(r0, 2 * vtile + (trp >> 1)) + 8 * (trp & 1)), tr_read(lds + HG_V + off_b(r1, 2 * vtile + (trp >> 1)) + 8 * (trp & 1)));
                o[vt] = __builtin_amdgcn_mfma_f32_16x16x32_bf16(a, pb[s2], o[vt], 0, 0, 0); }
        }
        float ss = 0.f;
#pragma unroll
        for (int vt = 0; vt < 4; ++vt) ss += (o[vt][0] * o[vt][0] + o[vt][1] * o[vt][1]) + (o[vt][2] * o[vt][2] + o[vt][3] * o[vt][3]);
        ss += __shfl_xor(ss, 16); ss += __shfl_xor(ss, 32);
        if (g == 0) red[wid * 16 + li] = ss;
        __syncthreads();
        const float tot2 = red[wid * 16 + li] + red[(wid ^ 4) * 16 + li];
        const float rstd = rsqrtf(tot2 * (1.0f / 128.0f) + EPS);
        bf16_t* yp = ycat + (size_t)(tok0 + tloc) * DM + 128 * h + 4 * g;
#pragma unroll
        for (int vt = 0; vt < 4; ++vt) { const int v0 = 16 * (4 * vh + vt); const u32x2 gwv = gw[vt];
            const float g0 = bflo(gwv.x), g1 = bfhi(gwv.x), g2 = bflo(gwv.y), g3 = bfhi(gwv.y);
            u32x2 w; w.x = cvt_pk_bf16(o[vt][0] * rstd * nv[vt][0] * g0 * sigmoidf_(g0), o[vt][1] * rstd * nv[vt][1] * g1 * sigmoidf_(g1));
            w.y = cvt_pk_bf16(o[vt][2] * rstd * nv[vt][2] * g2 * sigmoidf_(g2), o[vt][3] * rstd * nv[vt][3] * g3 * sigmoidf_(g3));
            *(u32x2*)(yp + v0) = w; }
#pragma unroll
        for (int vt = 0; vt < 4; ++vt) gw[vt] = gwn[vt];
        task = nxt;
    }
#undef H3_LOAD
}

__device__ void conv_fixup(const float* uedge, const float* cw, const float* cb, bf16_t* act, int pm, const int WID) {
    const bool hp = (pm & 15) != 0;
    const float* e = uedge + (size_t)pm * 4 * FF2; const float* ep = uedge + (size_t)(pm - 1) * 4 * FF2;
    for (int idx = TID_X; idx < 2 * FF; idx += 512) {
        const int r = idx / FF, j = idx - r * FF; const int cg_ = 256 * (j >> 7) + (j & 127);
        float uc[2];
#pragma unroll
        for (int bj = 0; bj < 2; ++bj) { const int cc = cg_ + 128 * bj, no = j + FF * bj;
            const float u0 = e[cc], u1 = e[FF2 + cc];
            const float p254 = hp ? ep[2 * FF2 + cc] : 0.f, p255 = hp ? ep[3 * FF2 + cc] : 0.f;
            const float c0 = cw[no], c1 = cw[FF2 + no], c2 = cw[2 * FF2 + no], bb = cb[no];
            uc[bj] = (r == 0) ? (bb + c2 * u0 + c1 * p255 + c0 * p254) : (bb + c2 * u1 + c1 * u0 + c0 * p255); }
        const float a = uc[0] * sigmoidf_(uc[0]) * uc[1];
        act[(size_t)(pm * 256 + r) * FF + j] = (bf16_t)(cvt_pk_bf16(a, 0.f) & 0xffff);
    }
}

#ifndef REP_P0
#define REP_P0 1
#endif
#ifndef REP_ATT
#define REP_ATT 1
#endif
#ifndef REP_H1
#define REP_H1 1
#endif
#ifndef REP_H2
#define REP_H2 1
#endif
#ifndef REP_H3
#define REP_H3 1
#endif
#ifndef REP_G1
#define REP_G1 1
#endif
#ifndef REP_G2
#define REP_G2 1
#endif
#ifndef REP_GPP
#define REP_GPP 1
#endif
#ifndef REP_G3
#define REP_G3 1
#endif
#ifndef REP_DUMMY
#define REP_DUMMY 0
#endif
#ifndef REP_SYNC
#define REP_SYNC 1
#endif
#define GSYNC() do { for (int s_ = 0; s_ < REP_SYNC; ++s_) xcd_barrier(xb, WID); } while (0)
__global__ void __launch_bounds__(512) mega(Params p) {
    extern __shared__ __attribute__((aligned(16))) unsigned char lds_raw[];
    LAS unsigned char* lds = (LAS unsigned char*)lds_raw;
    cg::grid_group grid = cg::this_grid();
    unsigned char* ws = p.ws;
    const int G = gridDim.x, bx = blockIdx.x;
    const int WID = __builtin_amdgcn_readfirstlane(threadIdx.x >> 6);
    volatile LAS unsigned* stw = (volatile LAS unsigned*)(lds + LDS_BYTES - 16);
    XcdBarrier xb; xb.bar = (unsigned*)(ws + WS_BAR); xb.x = xb_xcc_id(); xb.st = stw;
    if (threadIdx.x == 0) { stw[0] = 0u; stw[1] = 0u; stw[2] = xb_add(&xb.bar[XB_XCNT(xb.x)], 1u); stw[3] = 0u; }
    bf16_t* proj = (bf16_t*)(ws + WS_PROJ); bf16_t* ycat = (bf16_t*)(ws + WS_YCAT);

    for (int r_ = 0; r_ < REP_P0; ++r_) phase0(p, lds, WID);
    grid.sync();
    if (WID == 0 && lane_id_() == 0) { bool uni = (G == 256);
        for (int j = 0; j < 16; ++j) { const unsigned cnt = xb_ld(&xb.bar[XB_XCNT(j)]); uni = uni && (cnt == (j < 8 ? 32u : 0u)); }
        stw[3] = uni ? 1u : 0u; }
    __syncthreads();
    const bool uni_ = __builtin_amdgcn_readfirstlane((int)stw[3]) != 0; const int rank_ = __builtin_amdgcn_readfirstlane((int)stw[2]);
    const int cg_ = uni_ ? (rank_ * 8 + (int)xb.x) : bx, cl_ = uni_ ? ((int)xb.x * 32 + rank_) : bx;
    { pg8::Gemm g{(const bf16_t*)(ws + WS_XA), (const bf16_t*)(ws + WS_WIN), MTOK, INC, DM}; pg8::StaticOrder S; S.init(MTOK, INC, G, cg_);
      pg8::EpiPlainBf16 E{proj, INC, INC / 256}; for (int r_ = 0; r_ < REP_G1; ++r_) pg8::gemm_phase(WID, lds, g, S, E);
      pg8::EpiDummy ED{p.out}; for (int r_ = 0; r_ < REP_DUMMY; ++r_) pg8::gemm_phase<pg8::EpiDummy, true>(WID, lds, g, S, ED); }
    GSYNC();
    for (int r_ = 0; r_ < REP_H1; ++r_)
    hgrn_state_loop(proj, p.in[4], p.out, (float*)(ws + WS_DDEC), cl_, G, 2048, lds, WID);
    GSYNC();
    for (int st = 0; st < 2; ++st) {
        if ((st == 0) == ((cl_ & 1) == 0)) {
            for (int r_ = 0; r_ < REP_ATT; ++r_)
            for (int q = cl_; q < 512; q += G) attn_quad(proj, p.in[6], ycat, q, lds, WID);
        } else {
            for (int r_ = 0; r_ < REP_H2; ++r_)
            hgrn_scan(p.out, (const float*)(ws + WS_DDEC), (bf16_t*)(ws + WS_SST), WID);
        }
    }
    GSYNC();
    for (int r_ = 0; r_ < REP_H3; ++r_)
    hgrn_out_loop(proj, p.in[4], (const bf16_t*)(ws + WS_SST), p.in[5], ycat, cl_, G, 2048, lds, WID);
    GSYNC();
    { pg8::Gemm g{ycat, (const bf16_t*)(ws + WS_WOUT), MTOK, DM, DM}; pg8::StaticOrder S; S.init(MTOK, DM, G, cg_);
      pg8::EpiResid<false> E{p.in[0], (bf16_t*)(ws + WS_H1B), (float*)(ws + WS_SSQ1)}; for (int r_ = 0; r_ < REP_G2; ++r_) pg8::gemm_phase(WID, lds, g, S, E); }
    { pg8::Gemm g{(const bf16_t*)(ws + WS_PB), (const bf16_t*)(ws + WS_WPROJ), MTOK, DM, PLE}; pg8::StaticOrder S; S.init(MTOK, DM, G, cg_);
      pg8::EpiPlainBf16 E{(bf16_t*)(ws + WS_PP), DM, DM / 256, 0};     for (int r_ = 0; r_ < REP_GPP; ++r_) pg8::gemm_phase(WID, lds, g, S, E); }
    GSYNC();
    { pg8::Gemm g{(const bf16_t*)(ws + WS_H1B), (const bf16_t*)(ws + WS_WUP), MTOK, FF2, DM}; pg8::StaticOrder S; S.init(MTOK, FF2, G, cg_);
      pg8::EpiConv E{(const float*)(ws + WS_SSQ1), p.in[10], p.in[11], (bf16_t*)(ws + WS_ACT), (float*)(ws + WS_UEDGE), (LAS float*)(lds + pg8::STAGE_BYTES), (LAS float*)(lds + pg8::STAGE_BYTES + 8192), (LAS float*)(lds + pg8::STAGE_BYTES + 16384)};
      if (lane_id_() == 0) ((LAS int*)(lds + pg8::STAGE_BYTES + 16384 + 4096))[WID] = -1;
      __syncthreads();
      for (int r_ = 0; r_ < REP_G3; ++r_) pg8::gemm_phase(WID, lds, g, S, E); }
    GSYNC();
    { pg8::StaticOrder S; S.init(MTOK, DM, G, cg_); pg8::Unit u; int last = -1;
      for (int i = 0; S.next(i, u); ++i) if (u.pm != last) { conv_fixup((const float*)(ws + WS_UEDGE), p.in[10], p.in[11], (bf16_t*)(ws + WS_ACT), u.pm, WID); last = u.pm; }
      __threadfence(); __syncthreads();
      pg8::Gemm g{(const bf16_t*)(ws + WS_ACT), (const bf16_t*)(ws + WS_WDOWN), MTOK, DM, FF};
      pg8::EpiResid<true> E{(const void*)(ws + WS_H1B), (bf16_t*)(ws + WS_H1B), (float*)(ws + WS_SSQ2)}; pg8::gemm_phase(WID, lds, g, S, E); }
    GSYNC();
    { pg8::Gemm g{(const bf16_t*)(ws + WS_H1B), (const bf16_t*)(ws + WS_WGATE), MTOK, DM, DM}; pg8::StaticOrder S; S.init(MTOK, DM, G, cg_);
      pg8::EpiPle E{(const float*)(ws + WS_SSQ2), (const bf16_t*)(ws + WS_PP), (const bf16_t*)(ws + WS_H1B), (bf16_t*)(ws + WS_ACT), (float*)(ws + WS_SSQ3)}; pg8::gemm_phase(WID, lds, g, S, E); }
    GSYNC();
    { const int wid = WID, lane = lane_id_(); const float* fn = p.in[16]; const float* ssq = (const float*)(ws + WS_SSQ3); const bf16_t* h3b = (const bf16_t*)(ws + WS_ACT);
      for (int r = bx * 8 + wid; r < MTOK; r += G * 8) { float* xr = p.out + (size_t)r * DM; const bf16_t* hr = h3b + (size_t)r * DM;
          u32x4 hv[4];
#pragma unroll
          for (int i = 0; i < 4; ++i) hv[i] = *(const u32x4*)(hr + i * 512 + lane * 8);
          float s = (lane < 32) ? ssq[(size_t)r * 32 + lane] : 0.f;
#pragma unroll
          for (int o = 32; o >= 1; o >>= 1) s += __shfl_xor(s, o);
          const float rstd = rsqrtf(s * (1.0f / 2048.0f) + EPS);
#pragma unroll
          for (int i = 0; i < 4; ++i) { const f32x4 g0 = *(const f32x4*)(fn + i * 512 + lane * 8), g1 = *(const f32x4*)(fn + i * 512 + lane * 8 + 4);
              f32x4 a, b2; a[0] = bflo(hv[i].x) * rstd * g0[0]; a[1] = bfhi(hv[i].x) * rstd * g0[1]; a[2] = bflo(hv[i].y) * rstd * g0[2]; a[3] = bfhi(hv[i].y) * rstd * g0[3];
              b2[0] = bflo(hv[i].z) * rstd * g1[0]; b2[1] = bfhi(hv[i].z) * rstd * g1[1]; b2[2] = bflo(hv[i].w) * rstd * g1[2]; b2[3] = bfhi(hv[i].w) * rstd * g1[3];
              *(f32x4*)(xr + i * 512 + lane * 8) = a; *(f32x4*)(xr + i * 512 + lane * 8 + 4) = b2; } } }
}

extern "C" void kernel_launch(void* const* d_in, const int* in_sizes, int n_in, void* d_out, int out_size, void* d_ws, size_t ws_size, hipStream_t stream) {
    static int grid = 0;
    if (grid == 0) {
        if (n_in != 17 || out_size != MTOK * DM || ws_size < WS_END) { fprintf(stderr, "kernel_launch: unexpected shapes (n_in %d out %d ws %zu)\n", n_in, out_size, ws_size); grid = -1; return; }
        int dev = 0, cus = 0, per_cu = 0;
        (void)hipGetDevice(&dev);
        (void)hipDeviceGetAttribute(&cus, hipDeviceAttributeMultiprocessorCount, dev);
        if (hipFuncSetAttribute((const void*)mega, hipFuncAttributeMaxDynamicSharedMemorySize, LDS_BYTES) != hipSuccess) { fprintf(stderr, "hipFuncSetAttribute failed\n"); grid = -1; return; }
        if (hipOccupancyMaxActiveBlocksPerMultiprocessor(&per_cu, (const void*)mega, 512, LDS_BYTES) != hipSuccess || per_cu < 1) { fprintf(stderr, "occupancy query: %d\n", per_cu); (void)hipGetLastError(); grid = -1; return; }
        grid = cus;
    }
    if (grid < 0) return;
    Params p{};
    for (int i = 0; i < 17; ++i) p.in[i] = (const float*)d_in[i];
    p.out = (float*)d_out; p.ws = (unsigned char*)d_ws;
    void* args[] = {&p};
    if (hipMemsetAsync((unsigned char*)d_ws + WS_BAR, 0, XCD_BAR_WORDS * 4, stream) != hipSuccess) { fprintf(stderr, "memset failed\n"); return; }
    hipError_t e = hipLaunchCooperativeKernel((const void*)mega, dim3(grid), dim3(512), args, LDS_BYTES, stream);
    if (e != hipSuccess) fprintf(stderr, "cooperative launch failed: %s\n", hipGetErrorString(e));
}
```

```cpp
#include <hip/hip_runtime.h>
#include <hip/hip_cooperative_groups.h>
#include <cstdio>
namespace cg = cooperative_groups;

#define LAS __attribute__((address_space(3)))
typedef unsigned short bf16_t;
typedef short bf16x8 __attribute__((ext_vector_type(8)));
typedef short s16x4 __attribute__((ext_vector_type(4)));
typedef float f32x4 __attribute__((ext_vector_type(4)));
typedef float f32x2 __attribute__((ext_vector_type(2)));
typedef unsigned u32x4 __attribute__((ext_vector_type(4)));
typedef unsigned u32x2 __attribute__((ext_vector_type(2)));

constexpr int MTOK = 16384, DM = 2048, INC = 7168, FF = 5632, FF2 = 11264, PLE = 256, SEQ = 4096;
constexpr int LDS_BYTES = 149 * 1024;
constexpr float EPS = 1e-6f;
constexpr float LOG2E = 1.4426950408889634f;

constexpr size_t MiB = 1048576;
constexpr size_t WS_WIN = 0, WS_WOUT = 28 * MiB, WS_WUP = 36 * MiB, WS_WDOWN = 80 * MiB, WS_WGATE = 102 * MiB, WS_WPROJ = 110 * MiB;
constexpr size_t WS_PROJ = 111 * MiB;
constexpr size_t WS_XA = 335 * MiB;
constexpr size_t WS_YCAT = 335 * MiB;
constexpr size_t WS_SST = 399 * MiB;
constexpr size_t WS_DDEC = 463 * MiB;
constexpr size_t WS_SSQ1 = 464 * MiB, WS_SSQ2 = 466 * MiB, WS_SSQ3 = 468 * MiB;
constexpr size_t WS_PB = 470 * MiB;
constexpr size_t WS_H1B = 111 * MiB;
constexpr size_t WS_PP = 175 * MiB;
constexpr size_t WS_ACT = 239 * MiB;
constexpr size_t WS_UEDGE = 415 * MiB;
constexpr size_t WS_BAR = 478 * MiB;
constexpr size_t WS_END = 479 * MiB;

struct Params { const float* in[17]; float* out; unsigned char* ws; };

__device__ __forceinline__ unsigned cvt_pk_bf16(float lo, float hi) { unsigned r; asm volatile("v_cvt_pk_bf16_f32 %0, %1, %2" : "=v"(r) : "v"(lo), "v"(hi)); return r; }
__device__ __forceinline__ float bf2f(unsigned short b) { return __uint_as_float(((unsigned)b) << 16); }
__device__ __forceinline__ float bflo(unsigned w) { return __uint_as_float(w << 16); }
__device__ __forceinline__ float bfhi(unsigned w) { return __uint_as_float(w & 0xffff0000u); }
__device__ __forceinline__ float sigmoidf_(float x) { return __builtin_amdgcn_rcpf(1.0f + __expf(-x)); }
__device__ __forceinline__ size_t proj_off(int row, int col) {
    const int rl = row & 255, cl = col & 255; const size_t tb = (size_t)((row >> 8) * 28 + (col >> 8)) << 16;
    if (col < 2048) return tb + (size_t)((rl << 8) + cl);
    const int wv = ((rl >> 6) & 1) * 4 + ((cl >> 5) & 3), k = (((rl >> 7) & 1) * 4 + ((rl >> 4) & 3)) * 2 + ((cl >> 7) & 1), ln = ((cl >> 3) & 3) * 16 + (rl & 15);
    return tb + (size_t)((((wv * 16 + k) * 64 + ln) << 3) + (cl & 7));
}
__device__ __forceinline__ long proj_off_rm(int row, int col) { return ((long)((row >> 8) * 28 + (col >> 8)) << 16) + (long)(((row & 255) << 8) + (col & 255)); }
__device__ __forceinline__ long proj_off_fr(int row, int col) {
    const int rl = row & 255, cl = col & 255;
    const int wv = ((rl >> 6) & 1) * 4 + ((cl >> 5) & 3), k = (((rl >> 7) & 1) * 4 + ((rl >> 4) & 3)) * 2 + ((cl >> 7) & 1), ln = ((cl >> 3) & 3) * 16 + (rl & 15);
    return ((long)((row >> 8) * 28 + (col >> 8)) << 16) + (long)((((wv * 16 + k) * 64 + ln) << 3) + (cl & 7));
}
__device__ __forceinline__ unsigned off_b(unsigned row, unsigned ch) { return 256u * row + 16u * (ch ^ (((row & 3u) << 2) | ((row >> 2) & 3u))); }
__device__ __forceinline__ s16x4 tr_read(LAS unsigned char* p) { return __builtin_bit_cast(s16x4, __builtin_amdgcn_ds_read_tr16_b64_v4i16((LAS s16x4*)p)); }
__device__ __forceinline__ bf16x8 cat8(s16x4 a, s16x4 b) { return (bf16x8){a[0], a[1], a[2], a[3], b[0], b[1], b[2], b[3]}; }
__device__ __forceinline__ float dpp_ror1(float v) { return __int_as_float(__builtin_amdgcn_update_dpp(0, __float_as_int(v), 0x121, 0xf, 0xf, false)); }
__device__ __forceinline__ float dpp_shr1(float old, float v) { return __int_as_float(__builtin_amdgcn_update_dpp(__float_as_int(old), __float_as_int(v), 0x111, 0xf, 0xf, false)); }
__device__ __forceinline__ float dpp_shr2(float old, float v) { return __int_as_float(__builtin_amdgcn_update_dpp(__float_as_int(old), __float_as_int(v), 0x112, 0xf, 0xf, false)); }
__device__ __forceinline__ float dpp_ror2(float v) { return __int_as_float(__builtin_amdgcn_update_dpp(0, __float_as_int(v), 0x122, 0xf, 0xf, false)); }

__device__ __forceinline__ int lane_id_() { int l; asm volatile("v_mbcnt_lo_u32_b32 %0, -1, 0\n\tv_mbcnt_hi_u32_b32 %0, -1, %0" : "=v"(l)); return l; }
#define TID_X (WID * 64 + lane_id_())

#define XB_TMO      128
#define XB_XCNT(j)  (256  + 64 * (j))
#define XB_XSUB(j)  (1280 + 64 * (j))
#define XB_XGEN(j)  (2304 + 64 * (j))
#define XB_TOP      3328
#define XB_TOPGEN   3392
#define XCD_BAR_WORDS 3456
#define XB_SPIN_CAP (1u << 18)
__device__ __forceinline__ unsigned xb_ld(unsigned* p)              { return __hip_atomic_load(p, __ATOMIC_RELAXED, __HIP_MEMORY_SCOPE_AGENT); }
__device__ __forceinline__ unsigned xb_add(unsigned* p, unsigned v) { return __hip_atomic_fetch_add(p, v, __ATOMIC_RELAXED, __HIP_MEMORY_SCOPE_AGENT); }
__device__ __forceinline__ unsigned xb_xcc_id() { return (unsigned)__builtin_amdgcn_s_getreg((3 << 11) | 20) & 0xFu; }
#define XB_SPIN(cond, bar) do { unsigned _sp = 0; while (cond) { __builtin_amdgcn_s_sleep(1); \
    if ((++_sp & 255u) == 0u) { if (xb_ld(&(bar)[XB_TMO])) break; if (_sp > XB_SPIN_CAP) { atomicAdd(&(bar)[XB_TMO], 1u); break; } } } } while (0)
struct XcdBarrier { unsigned* bar; unsigned x; volatile LAS unsigned* st; };
__device__ __forceinline__ void xcd_barrier_complete(unsigned* bar, unsigned x, unsigned& nloc, unsigned& nx) {
    const unsigned G = gridDim.x;
    unsigned sum, cnt, mine, sp = 0u;
    for (;;) {
        sum = 0u; cnt = 0u; mine = 0u;
#pragma unroll
        for (unsigned j = 0; j < 16; ++j) { const unsigned c = xb_ld(&bar[XB_XCNT(j)]); sum += c; cnt += (c > 0u) ? 1u : 0u; mine = (j == x) ? c : mine; }
        if (sum == G) break;
        __builtin_amdgcn_s_sleep(1);
        if ((++sp & 255u) == 0u) { if (xb_ld(&bar[XB_TMO])) break; if (sp > XB_SPIN_CAP) { atomicAdd(&bar[XB_TMO], 1u); break; } }
    }
    nloc = mine > 0u ? mine : 1u; nx = cnt > 0u ? cnt : 1u;
}
__device__ __forceinline__ void xcd_barrier(const XcdBarrier& b, const int WID) {
    asm volatile("s_waitcnt vmcnt(0)" ::: "memory");
    __syncthreads();
    if (WID == 0 && lane_id_() == 0) {
        unsigned* bar = b.bar;
        __builtin_amdgcn_s_waitcnt(0);
        unsigned nloc = b.st[0], nx = b.st[1];
        if (nloc == 0u) { xcd_barrier_complete(bar, b.x, nloc, nx); b.st[0] = nloc; b.st[1] = nx; }
        const unsigned old = xb_add(&bar[XB_XSUB(b.x)], 1u);
        const unsigned gen = old / nloc;
        if (old + 1u == (gen + 1u) * nloc) {
            __builtin_amdgcn_fence(__ATOMIC_RELEASE, "agent");
            asm volatile("s_waitcnt vmcnt(0)" ::: "memory");
            const unsigned og = xb_add(&bar[XB_TOP], 1u);
            const unsigned tg = og / nx;
            if (og + 1u == (tg + 1u) * nx) xb_add(&bar[XB_TOPGEN], 1u);
            else XB_SPIN(xb_ld(&bar[XB_TOPGEN]) == tg, bar);
            __builtin_amdgcn_fence(__ATOMIC_ACQUIRE, "agent");
            xb_add(&bar[XB_XGEN(b.x)], 1u);
            asm volatile("s_waitcnt vmcnt(0)" ::: "memory");
        } else {
            XB_SPIN(xb_ld(&bar[XB_XGEN(b.x)]) == gen, bar);
            __builtin_amdgcn_fence(__ATOMIC_ACQUIRE, "agent");
            asm volatile("s_waitcnt vmcnt(0)" ::: "memory");
        }
    }
    __syncthreads();
}

namespace pg8 {
constexpr int BM = 256, BK = 64, HALF = 128, HTB = HALF * BK * 2, STAGE_BYTES = 8 * HTB, NXCD = 8, WGM = 8;
__device__ __forceinline__ int lds_byte(int r, int c) { const int st = (r >> 4) * 2 + (c >> 5), rr = r & 15, cc = c & 31, ob = rr * 64 + cc * 2; return st * 1024 + (ob ^ (((ob >> 9) & 1) << 5)); }
__device__ __forceinline__ void stage_rc(int b, int& R, int& C) { const int st = b / 1024, sb = b % 1024, swz = sb ^ (((sb >> 9) & 1) << 5); R = (st >> 1) * 16 + swz / 64; C = (st & 1) * 32 + (swz % 64) / 2; }
__device__ __forceinline__ int perm32(int rho) { const int n = rho >> 4, i = rho & 15; return 8 * (i >> 2) + 4 * n + (i & 3); }
struct Unit { int pm, pn; };
struct Gemm { const bf16_t* A; const bf16_t* Bt; int M, N, K; };
struct StaticOrder {
    int nM, nN, nwg, G, c;
    __device__ void init(int M, int N, int G_, int c_) { nM = M / BM; nN = N / BM; nwg = nM * nN; G = G_; c = c_; }
    __device__ bool next(int i, Unit& u) const {
        const long L = (long)i * G + c; if (L >= nwg) return false;
        int wgid = (int)L; { const int q = nwg / NXCD, r = nwg % NXCD, xcd = wgid % NXCD, off = wgid / NXCD; wgid = (xcd < r ? xcd * (q + 1) : r * (q + 1) + (xcd - r) * q) + off; }
        const int nig = WGM * nN, gid = wgid / nig, fm = gid * WGM, gsz = (nM - fm) < WGM ? (nM - fm) : WGM;
        u.pm = fm + ((wgid % nig) % gsz); u.pn = (wgid % nig) / gsz; return true;
    }
};

template <class Epi, bool KS0 = false>
__device__ __forceinline__ void gemm_phase(const int WID, LAS unsigned char* lds, const Gemm g, const StaticOrder& S, const Epi& E) {
    const int wid = WID, lane = lane_id_(), tid = wid * 64 + lane, wr = wid >> 2, wc = wid & 3, fr = lane & 15, fq = lane >> 4;
    const int K = g.K, nt = K / BK;
    unsigned voffA[2], voffB[2];
#pragma unroll
    for (int i = 0; i < 2; ++i) { int R, C; stage_rc(tid * 16 + i * 8192, R, C); const int Rb = Epi::PERM ? ((R & ~31) + perm32(R & 31)) : R;
        voffA[i] = (unsigned)(R * K + C) * 2u; voffB[i] = (unsigned)(Rb * K + C) * 2u; }
    const size_t kstep = KS0 ? (size_t)0 : (size_t)(BK * 2);
    const size_t hstep = (size_t)HALF * K * 2;
    const size_t tstep = 2 * hstep;
    const unsigned ldsw = (unsigned)wid * 1024u;
    const int aoff = lds_byte(wr * 64 + fr, fq * 8), boff = lds_byte(wc * 32 + fr, fq * 8);
#define PG8_SA(b, h) (((b) * 2 + (h)) * HTB)
#define PG8_SB(b, h) ((4 + (b) * 2 + (h)) * HTB)
#define PG8_STAGE(bufoff, gbase, voff) do { _Pragma("unroll") for (int _i = 0; _i < 2; ++_i) \
        __builtin_amdgcn_global_load_lds((const unsigned*)((const char*)(gbase) + (voff)[_i]), (LAS unsigned*)(lds + (bufoff) + ldsw + _i * 8192), 16, 0, 0); } while (0)
#define PG8_LDA(dst, b, h) do { _Pragma("unroll") for (int m = 0; m < 4; ++m) _Pragma("unroll") for (int k = 0; k < 2; ++k) dst[m][k] = *(const LAS bf16x8*)(lds + PG8_SA(b, h) + aoff + m * 2048 + k * 1024); } while (0)
#define PG8_LDB(dst, b, h) do { _Pragma("unroll") for (int n = 0; n < 2; ++n) _Pragma("unroll") for (int k = 0; k < 2; ++k) dst[n][k] = *(const LAS bf16x8*)(lds + PG8_SB(b, h) + boff + n * 2048 + k * 1024); } while (0)
#define PG8_MMA(ai, bj, At, Bt) do { __builtin_amdgcn_s_setprio(1); _Pragma("unroll") for (int m = 0; m < 4; ++m) _Pragma("unroll") for (int n = 0; n < 2; ++n) _Pragma("unroll") for (int k = 0; k < 2; ++k) \
        acc[ai][bj][m][n] = __builtin_amdgcn_mfma_f32_16x16x32_bf16(Bt[n][k], At[m][k], acc[ai][bj][m][n], 0, 0, 0); __builtin_amdgcn_s_setprio(0); } while (0)
#define PG8_WAIT_V(n) asm volatile("s_waitcnt vmcnt(" #n ")" ::: "memory")
#define PG8_WAIT_L(n) asm volatile("s_waitcnt lgkmcnt(" #n ")" ::: "memory")
#define PG8_BAR __builtin_amdgcn_s_barrier()
#define PG8_SCHED __builtin_amdgcn_sched_barrier(0)
    Unit cur, nxt; int ui = 0;
    if (!S.next(0, cur)) return;
    f32x4 acc[2][2][4][2];
#pragma unroll
    for (int a = 0; a < 2; ++a)
#pragma unroll
        for (int b = 0; b < 2; ++b)
#pragma unroll
            for (int m = 0; m < 4; ++m)
#pragma unroll
                for (int n = 0; n < 2; ++n) acc[a][b][m][n] = (f32x4){0.f, 0.f, 0.f, 0.f};
    bf16x8 At[4][2], B0[2][2], B1[2][2];
    const char* cA = (const char*)g.A + (size_t)cur.pm * tstep; const char* cB = (const char*)g.Bt + (size_t)cur.pn * tstep;
    PG8_STAGE(PG8_SB(0, 0), cB, voffB); PG8_STAGE(PG8_SA(0, 0), cA, voffA); PG8_STAGE(PG8_SB(0, 1), cB + hstep, voffB); PG8_STAGE(PG8_SA(0, 1), cA + hstep, voffA);
    if (wr == 1) PG8_BAR;
    PG8_WAIT_V(4); PG8_BAR;
    PG8_STAGE(PG8_SB(1, 0), cB + kstep, voffB); PG8_STAGE(PG8_SA(1, 0), cA + kstep, voffA); PG8_STAGE(PG8_SB(1, 1), cB + hstep + kstep, voffB);
    PG8_WAIT_V(6); PG8_BAR;
    for (;;) {
        const bool has_next = S.next(ui + 1, nxt);
        const char* nA = has_next ? (const char*)g.A + (size_t)nxt.pm * tstep : cA; const char* nB = has_next ? (const char*)g.Bt + (size_t)nxt.pn * tstep : cB;
        for (int t = 0; t < nt; t += 2) {
            const bool last = (t == nt - 2);
            const char* a1 = cA + (size_t)(t + 1) * kstep;
            const char* a2 = last ? nA : cA + (size_t)(t + 2) * kstep; const char* b2 = last ? nB : cB + (size_t)(t + 2) * kstep;
            const char* a3 = a2 + kstep; const char* b3 = b2 + kstep;
            PG8_LDB(B0, 0, 0); PG8_SCHED; PG8_LDA(At, 0, 0); PG8_STAGE(PG8_SA(1, 1), a1 + hstep, voffA);
            PG8_WAIT_L(8); PG8_BAR; PG8_WAIT_L(0); PG8_MMA(0, 0, At, B0); PG8_BAR; PG8_SCHED;
            PG8_LDB(B1, 0, 1); PG8_STAGE(PG8_SB(0, 0), b2, voffB);
            PG8_BAR; PG8_WAIT_L(0); PG8_MMA(0, 1, At, B1); PG8_BAR;
            PG8_LDA(At, 0, 1); PG8_STAGE(PG8_SA(0, 0), a2, voffA);
            PG8_BAR; PG8_WAIT_L(0); PG8_MMA(1, 0, At, B0); PG8_BAR; PG8_SCHED;
            PG8_STAGE(PG8_SB(0, 1), b2 + hstep, voffB);
            PG8_WAIT_V(6); PG8_BAR; PG8_MMA(1, 1, At, B1); PG8_BAR;
            PG8_LDB(B0, 1, 0); PG8_SCHED; PG8_LDA(At, 1, 0); PG8_STAGE(PG8_SA(0, 1), a2 + hstep, voffA);
            PG8_WAIT_L(8); PG8_BAR; PG8_WAIT_L(0); PG8_MMA(0, 0, At, B0); PG8_BAR; PG8_SCHED;
            PG8_LDB(B1, 1, 1); PG8_STAGE(PG8_SB(1, 0), b3, voffB);
            PG8_BAR; PG8_WAIT_L(0); PG8_MMA(0, 1, At, B1); PG8_BAR;
            PG8_LDA(At, 1, 1); PG8_STAGE(PG8_SA(1, 0), a3, voffA);
            PG8_BAR; PG8_WAIT_L(0); PG8_MMA(1, 0, At, B0); PG8_BAR; PG8_SCHED;
            PG8_STAGE(PG8_SB(1, 1), b3 + hstep, voffB);
            PG8_WAIT_V(6); PG8_BAR; PG8_MMA(1, 1, At, B1); PG8_BAR;
        }
        { int fr2 = lane_id_(), fq2; fq2 = fr2 >> 4; fr2 &= 15; asm volatile("" : "+v"(fr2), "+v"(fq2)); E(acc, cur, wr, wc, fr2, fq2); }
        if (!has_next) break;
#pragma unroll
        for (int a = 0; a < 2; ++a)
#pragma unroll
            for (int b = 0; b < 2; ++b)
#pragma unroll
                for (int m = 0; m < 4; ++m)
#pragma unroll
                    for (int n = 0; n < 2; ++n) acc[a][b][m][n] = (f32x4){0.f, 0.f, 0.f, 0.f};
        cur = nxt; cA = nA; cB = nB; ++ui;
    }
    PG8_WAIT_V(0);
    if (wr == 0) PG8_BAR;
    PG8_BAR;
#undef PG8_SA
#undef PG8_SB
#undef PG8_STAGE
#undef PG8_LDA
#undef PG8_LDB
#undef PG8_MMA
#undef PG8_WAIT_V
#undef PG8_WAIT_L
#undef PG8_SCHED
}

struct EpiPlainBf16 {
    static constexpr bool PERM = true;
    bf16_t* O; int ldc; int frag = 0; int fmin = 8;
    __device__ __forceinline__ void operator()(f32x4 (&acc)[2][2][4][2], const Unit& u, int wr, int wc, int fr, int fq) const {
        bf16_t* base; size_t s_ai, s_m, s_bj;
        if (frag && u.pn >= fmin) { base = O + ((size_t)(u.pm * frag + u.pn) << 16) + (size_t)((((wr * 4 + wc) * 16) * 64 + fq * 16 + fr) << 3); s_ai = 4096; s_m = 1024; s_bj = 512; }
        else if (frag) { base = O + ((size_t)(u.pm * frag + u.pn) << 16) + (size_t)(((wr * 64 + fr) << 8) + wc * 32 + 8 * fq); s_ai = (size_t)HALF * 256; s_m = 16 * 256; s_bj = HALF; }
        else { base = O + (size_t)(u.pm * BM + wr * 64 + fr) * ldc + u.pn * BM + wc * 32 + 8 * fq; s_ai = (size_t)HALF * ldc; s_m = (size_t)16 * ldc; s_bj = HALF; }
#pragma unroll
        for (int ai = 0; ai < 2; ++ai)
#pragma unroll
            for (int m = 0; m < 4; ++m)
#pragma unroll
                for (int bj = 0; bj < 2; ++bj) { const f32x4 v0 = acc[ai][bj][m][0], v1 = acc[ai][bj][m][1];
                    u32x4 w; w.x = cvt_pk_bf16(v0[0], v0[1]); w.y = cvt_pk_bf16(v0[2], v0[3]); w.z = cvt_pk_bf16(v1[0], v1[1]); w.w = cvt_pk_bf16(v1[2], v1[3]);
                    *(u32x4*)(base + ai * s_ai + m * s_m + bj * s_bj) = w; }
    }
};
struct EpiDummy {
    static constexpr bool PERM = true;
    float* O;
    __device__ __forceinline__ void operator()(f32x4 (&acc)[2][2][4][2], const Unit& u, int wr, int wc, int fr, int fq) const {
        float s = 0.f;
#pragma unroll
        for (int ai = 0; ai < 2; ++ai)
#pragma unroll
            for (int bj = 0; bj < 2; ++bj)
#pragma unroll
                for (int m = 0; m < 4; ++m)
#pragma unroll
                    for (int n = 0; n < 2; ++n) s += (acc[ai][bj][m][n][0] + acc[ai][bj][m][n][1]) + (acc[ai][bj][m][n][2] + acc[ai][bj][m][n][3]);
        if (s == 12345.678f) O[u.pm * 256 + fr] = s;
    }
};
__device__ __forceinline__ float row_rstd(const float* ssq, int row, int fq) {
    const f32x4 a = *(const f32x4*)(ssq + (size_t)row * 32 + 8 * fq), b = *(const f32x4*)(ssq + (size_t)row * 32 + 8 * fq + 4);
    float t = ((a[0] + a[1]) + (a[2] + a[3])) + ((b[0] + b[1]) + (b[2] + b[3]));
    t += __shfl_xor(t, 16); t += __shfl_xor(t, 32);
    return rsqrtf(t * (1.0f / 2048.0f) + EPS);
}
template <bool RB>
struct EpiResid {
    static constexpr bool PERM = true;
    const void* res; bf16_t* outb; float* ssq;
    __device__ __forceinline__ void operator()(f32x4 (&acc)[2][2][4][2], const Unit& u, int wr, int wc, int fr, int fq) const {
        const int row0 = u.pm * BM + wr * 64 + fr, col0 = u.pn * BM + wc * 32 + 8 * fq;
#pragma unroll
        for (int ai = 0; ai < 2; ++ai) {
            f32x4 r[4][2][2];
#pragma unroll
            for (int m = 0; m < 4; ++m)
#pragma unroll
                for (int bj = 0; bj < 2; ++bj) { const size_t o = (size_t)(row0 + ai * HALF + m * 16) * DM + col0 + bj * HALF;
                    if (RB) { const u32x4 w = *(const u32x4*)((const bf16_t*)res + o); r[m][bj][0] = (f32x4){bflo(w.x), bfhi(w.x), bflo(w.y), bfhi(w.y)}; r[m][bj][1] = (f32x4){bflo(w.z), bfhi(w.z), bflo(w.w), bfhi(w.w)}; }
                    else { r[m][bj][0] = *(const f32x4*)((const float*)res + o); r[m][bj][1] = *(const f32x4*)((const float*)res + o + 4); } }
#pragma unroll
            for (int m = 0; m < 4; ++m) { const int row = row0 + ai * HALF + m * 16; const size_t off = (size_t)row * DM + col0; float s = 0.f;
#pragma unroll
                for (int bj = 0; bj < 2; ++bj) { const f32x4 v0 = acc[ai][bj][m][0] + r[m][bj][0], v1 = acc[ai][bj][m][1] + r[m][bj][1];
                    u32x4 w; w.x = cvt_pk_bf16(v0[0], v0[1]); w.y = cvt_pk_bf16(v0[2], v0[3]); w.z = cvt_pk_bf16(v1[0], v1[1]); w.w = cvt_pk_bf16(v1[2], v1[3]);
                    *(u32x4*)(outb + off + bj * HALF) = w;
                    s += ((v0[0] * v0[0] + v0[1] * v0[1]) + (v0[2] * v0[2] + v0[3] * v0[3])) + ((v1[0] * v1[0] + v1[1] * v1[1]) + (v1[2] * v1[2] + v1[3] * v1[3])); }
                s += __shfl_xor(s, 16); s += __shfl_xor(s, 32);
                if (fq == 0) ssq[(size_t)row * 32 + u.pn * 4 + wc] = s; }
            asm volatile("" ::: "memory"); }
    }
};
struct EpiPle {
    static constexpr bool PERM = true;
    const float* ssq_in; const bf16_t* pp; const bf16_t* hb; bf16_t* out; float* ssq;
    __device__ __forceinline__ void operator()(f32x4 (&acc)[2][2][4][2], const Unit& u, int wr, int wc, int fr, int fq) const {
        const int row0 = u.pm * BM + wr * 64 + fr, col0 = u.pn * BM + wc * 32 + 8 * fq;
        const bf16_t* ppf = pp + ((size_t)(u.pm * (DM / 256) + u.pn) << 16) + (size_t)((((wr * 4 + wc) * 16) * 64 + fq * 16 + fr) << 3);
#pragma unroll
        for (int ai = 0; ai < 2; ++ai) {
            u32x4 hw[4][2], pw[4][2]; float rstd[4];
#pragma unroll
            for (int m = 0; m < 4; ++m) { const int row = row0 + ai * HALF + m * 16;
#pragma unroll
                for (int bj = 0; bj < 2; ++bj) { const size_t o = (size_t)row * DM + col0 + bj * HALF; hw[m][bj] = *(const u32x4*)(hb + o); pw[m][bj] = *(const u32x4*)(ppf + (((ai * 4 + m) * 2 + bj) << 9)); }
                rstd[m] = row_rstd(ssq_in, row, fq); }
#pragma unroll
            for (int m = 0; m < 4; ++m) { const int row = row0 + ai * HALF + m * 16; const size_t off = (size_t)row * DM + col0; float s = 0.f;
#pragma unroll
                for (int bj = 0; bj < 2; ++bj) { const f32x4 z0 = acc[ai][bj][m][0] * rstd[m], z1 = acc[ai][bj][m][1] * rstd[m]; const u32x4 h2 = hw[m][bj], p2 = pw[m][bj]; f32x4 v0, v1;
                    v0[0] = bflo(h2.x) + sigmoidf_(z0[0]) * bflo(p2.x); v0[1] = bfhi(h2.x) + sigmoidf_(z0[1]) * bfhi(p2.x);
                    v0[2] = bflo(h2.y) + sigmoidf_(z0[2]) * bflo(p2.y); v0[3] = bfhi(h2.y) + sigmoidf_(z0[3]) * bfhi(p2.y);
                    v1[0] = bflo(h2.z) + sigmoidf_(z1[0]) * bflo(p2.z); v1[1] = bfhi(h2.z) + sigmoidf_(z1[1]) * bfhi(p2.z);
                    v1[2] = bflo(h2.w) + sigmoidf_(z1[2]) * bflo(p2.w); v1[3] = bfhi(h2.w) + sigmoidf_(z1[3]) * bfhi(p2.w);
                    u32x4 w; w.x = cvt_pk_bf16(v0[0], v0[1]); w.y = cvt_pk_bf16(v0[2], v0[3]); w.z = cvt_pk_bf16(v1[0], v1[1]); w.w = cvt_pk_bf16(v1[2], v1[3]);
                    *(u32x4*)(out + off + bj * HALF) = w;
                    s += ((v0[0] * v0[0] + v0[1] * v0[1]) + (v0[2] * v0[2] + v0[3] * v0[3])) + ((v1[0] * v1[0] + v1[1] * v1[1]) + (v1[2] * v1[2] + v1[3] * v1[3])); }
                s += __shfl_xor(s, 16); s += __shfl_xor(s, 32);
                if (fq == 0) ssq[(size_t)row * 32 + u.pn * 4 + wc] = s; }
            asm volatile("" ::: "memory"); }
    }
};
struct EpiConv {
    static constexpr bool PERM = false;
    const float* ssq_in; const float* cw; const float* cb; bf16_t* act; float* uedge; LAS float* ex; LAS float* cws; LAS float* rsl;
    __device__ __forceinline__ void conv_rows(const f32x4 curg, const f32x4 curv, f32x4 (&q1)[2], f32x4 (&q2)[2], const LAS float* cp, bf16_t* dst, const bool upd) const {
        f32x4 uc[2];
#pragma unroll
        for (int bj = 0; bj < 2; ++bj) {
            const f32x4 c0 = *(const LAS f32x4*)(cp + bj * 32), c1 = *(const LAS f32x4*)(cp + bj * 32 + 64), c2 = *(const LAS f32x4*)(cp + bj * 32 + 128), bb = *(const LAS f32x4*)(cp + bj * 32 + 192);
            const f32x4 cur = bj ? curv : curg;
#pragma unroll
            for (int e = 0; e < 4; ++e) {
                const float p1 = dpp_shr1(q1[bj][e], cur[e]), p2 = dpp_shr2(q2[bj][e], cur[e]);
                uc[bj][e] = bb[e] + c0[e] * p2 + c1[e] * p1 + c2[e] * cur[e];
                if (upd) { q1[bj][e] = dpp_ror1(cur[e]); q2[bj][e] = dpp_ror2(cur[e]); }
            }
        }
        u32x2 w;
        { const float a0 = uc[0][0] * sigmoidf_(uc[0][0]) * uc[1][0], a1 = uc[0][1] * sigmoidf_(uc[0][1]) * uc[1][1];
          const float a2 = uc[0][2] * sigmoidf_(uc[0][2]) * uc[1][2], a3 = uc[0][3] * sigmoidf_(uc[0][3]) * uc[1][3];
          w.x = cvt_pk_bf16(a0, a1); w.y = cvt_pk_bf16(a2, a3); }
        *(u32x2*)dst = w;
    }
    __device__ __forceinline__ void operator()(f32x4 (&acc)[2][2][4][2], const Unit& u, int wr, int wc, int fr, int fq) const {
        const int rowt = u.pm * BM + wr * 64 + fr, cl0 = wc * 32 + 4 * fq, wv = wr * 4 + wc, ln = fq * 16 + fr;
        float cwr[4];
#pragma unroll
        for (int i = 0; i < 4; ++i) { const float* srcp = (i < 3) ? (cw + (size_t)i * FF2) : cb; cwr[i] = srcp[(ln >> 5) * FF + u.pn * HALF + wc * 32 + (ln & 31)]; }
        {
            LAS float* myr = rsl + wv * 128; LAS int* mypm = (LAS int*)(rsl + 1024) + wv;
            if (__builtin_amdgcn_readfirstlane(*mypm) != u.pm) {
#pragma unroll
                for (int ai = 0; ai < 2; ++ai)
#pragma unroll
                    for (int m = 0; m < 4; ++m) { const float r_ = row_rstd(ssq_in, rowt + ai * HALF + m * 16, fq); if (fq == 0) myr[(ai * 4 + m) * 16 + fr] = r_; }
                if (fq == 0 && fr == 0) *mypm = u.pm;
                asm volatile("s_waitcnt lgkmcnt(0)" ::: "memory");
            }
#pragma unroll
            for (int ai = 0; ai < 2; ++ai)
#pragma unroll
                for (int m = 0; m < 4; ++m) { const float rstd = myr[(ai * 4 + m) * 16 + fr];
#pragma unroll
                    for (int bj = 0; bj < 2; ++bj)
#pragma unroll
                        for (int n = 0; n < 2; ++n) acc[ai][bj][m][n] *= rstd; }
        }
        if (fr >= 14) {
#pragma unroll
            for (int ai = 0; ai < 2; ++ai)
#pragma unroll
                for (int bj = 0; bj < 2; ++bj)
#pragma unroll
                    for (int n = 0; n < 2; ++n) *(LAS f32x4*)(ex + (((ai * 2 + wr) * 2 + (fr - 14)) * 256 + bj * HALF + cl0 + n * 16)) = acc[ai][bj][3][n];
        }
        if (wr == 0 && fr < 2) {
#pragma unroll
            for (int bj = 0; bj < 2; ++bj)
#pragma unroll
                for (int n = 0; n < 2; ++n) *(f32x4*)(uedge + ((size_t)(u.pm * 4 + fr) * FF2 + u.pn * BM + bj * HALF + cl0 + n * 16)) = acc[0][bj][0][n];
        }
        if (wr == 1 && fr >= 14) {
#pragma unroll
            for (int bj = 0; bj < 2; ++bj)
#pragma unroll
                for (int n = 0; n < 2; ++n) *(f32x4*)(uedge + ((size_t)(u.pm * 4 + 2 + (fr - 14)) * FF2 + u.pn * BM + bj * HALF + cl0 + n * 16)) = acc[1][bj][3][n];
        }
        LAS float* myc = cws + wv * 256;
#pragma unroll
        for (int i = 0; i < 4; ++i) myc[i * 64 + ln] = cwr[i];
        asm volatile("s_waitcnt lgkmcnt(0)" ::: "memory");
#pragma unroll
        for (int n = 0; n < 2; ++n) {
            const int jcol = u.pn * HALF + cl0 + n * 16; const LAS float* cp = myc + 16 * n + 4 * fq;
#pragma unroll
            for (int ai = 0; ai < 2; ++ai) {
                f32x4 q1[2], q2[2];
#pragma unroll
                for (int bj = 0; bj < 2; ++bj)
#pragma unroll
                    for (int e = 0; e < 4; ++e) { q1[bj][e] = dpp_ror1(acc[ai][bj][0][n][e]); q2[bj][e] = dpp_ror2(acc[ai][bj][0][n][e]); }
#pragma unroll
                for (int m = 1; m < 4; ++m) conv_rows(acc[ai][0][m][n], acc[ai][1][m][n], q1, q2, cp, act + (size_t)(rowt + ai * HALF + m * 16) * FF + jcol, m < 3);
            }
        }
        asm volatile("s_waitcnt lgkmcnt(0)" ::: "memory"); PG8_BAR; PG8_BAR; asm volatile("" ::: "memory");
#pragma unroll
        for (int n = 0; n < 2; ++n) {
            const int jcol = u.pn * HALF + cl0 + n * 16; const LAS float* cp = myc + 16 * n + 4 * fq;
#pragma unroll
            for (int ai = 0; ai < 2; ++ai) {
                const bool has_prev = !(ai == 0 && wr == 0);
                const int slot = (wr == 1) ? (ai * 2) : ((ai - 1) * 2 + 1);
                f32x4 q1[2], q2[2];
#pragma unroll
                for (int bj = 0; bj < 2; ++bj) {
                    f32x4 e0 = (f32x4){0.f, 0.f, 0.f, 0.f}, e1 = (f32x4){0.f, 0.f, 0.f, 0.f};
                    if (has_prev) { e0 = *(const LAS f32x4*)(ex + ((slot * 2 + 0) * 256 + bj * HALF + cl0 + n * 16)); e1 = *(const LAS f32x4*)(ex + ((slot * 2 + 1) * 256 + bj * HALF + cl0 + n * 16)); }
                    q1[bj] = e1;
#pragma unroll
                    for (int e = 0; e < 4; ++e) q2[bj][e] = (fr == 1) ? e1[e] : e0[e];
                }
                conv_rows(acc[ai][0][0][n], acc[ai][1][0][n], q1, q2, cp, act + (size_t)(rowt + ai * HALF) * FF + jcol, false);
            }
        }
    }
};
#undef PG8_BAR
}

__device__ void phase0(const Params& p, LAS unsigned char* lds, const int WID) {
    unsigned char* ws = p.ws;
    const int G = gridDim.x, bx = blockIdx.x, wid = WID, lane = lane_id_(), tid = wid * 64 + lane;
    { const float* x = p.in[0]; const float* gm = p.in[2]; bf16_t* xa = (bf16_t*)(ws + WS_XA);
      for (int r = bx * 8 + wid; r < MTOK; r += G * 8) { const float* xr = x + (size_t)r * DM; f32x4 v[8]; float s = 0.f;
#pragma unroll
          for (int i = 0; i < 8; ++i) { v[i] = __builtin_nontemporal_load((const f32x4*)(xr + i * 256 + lane * 4)); s += (v[i][0] * v[i][0] + v[i][1] * v[i][1]) + (v[i][2] * v[i][2] + v[i][3] * v[i][3]); }
#pragma unroll
          for (int o = 32; o >= 1; o >>= 1) s += __shfl_xor(s, o);
          const float rstd = rsqrtf(s * (1.0f / 2048.0f) + EPS);
#pragma unroll
          for (int i = 0; i < 8; ++i) { const f32x4 gv = *(const f32x4*)(gm + i * 256 + lane * 4); u32x2 w; w.x = cvt_pk_bf16(v[i][0] * rstd * gv[0], v[i][1] * rstd * gv[1]); w.y = cvt_pk_bf16(v[i][2] * rstd * gv[2], v[i][3] * rstd * gv[3]);
              *(u32x2*)(xa + (size_t)r * DM + i * 256 + lane * 4) = w; } } }
    { const float* pin = p.in[1]; bf16_t* pb = (bf16_t*)(ws + WS_PB);
      for (int i = bx * 512 + tid; i < MTOK * PLE / 4; i += G * 512) { const f32x4 v = __builtin_nontemporal_load((const f32x4*)(pin + (size_t)i * 4)); u32x2 w; w.x = cvt_pk_bf16(v[0], v[1]); w.y = cvt_pk_bf16(v[2], v[3]); *(u32x2*)(pb + (size_t)i * 4) = w; } }
    constexpr int J0 = 16 * 112, J1 = J0 + 16 * 32, J2 = J1 + 16 * 176, J3 = J2 + 44 * 32, J4 = J3 + 16 * 32, J5 = J4 + 2 * 32;
    const float* src = nullptr; bf16_t* dst = nullptr; const float* scale = nullptr; int K = 0, N = 0, mode = 0, k0 = 0, n0 = 0;
#define P0_DECODE(job) do { int tp_; \
        if ((job) < J0) { src = p.in[3]; dst = (bf16_t*)(ws + WS_WIN); scale = nullptr; K = DM; N = INC; mode = 0; tp_ = (job); } \
        else if ((job) < J1) { src = p.in[7]; dst = (bf16_t*)(ws + WS_WOUT); scale = nullptr; K = DM; N = DM; mode = 0; tp_ = (job) - J0; } \
        else if ((job) < J2) { src = p.in[9]; dst = (bf16_t*)(ws + WS_WUP); scale = p.in[8]; K = DM; N = FF2; mode = 1; tp_ = (job) - J1; } \
        else if ((job) < J3) { src = p.in[12]; dst = (bf16_t*)(ws + WS_WDOWN); scale = nullptr; K = FF; N = DM; mode = 0; tp_ = (job) - J2; } \
        else if ((job) < J4) { src = p.in[14]; dst = (bf16_t*)(ws + WS_WGATE); scale = p.in[13]; K = DM; N = DM; mode = 0; tp_ = (job) - J3; } \
        else { src = p.in[15]; dst = (bf16_t*)(ws + WS_WPROJ); scale = nullptr; K = PLE; N = DM; mode = 0; tp_ = (job) - J4; } \
        const int nk2_ = K >> 7; k0 = (tp_ % nk2_) * 128; n0 = (tp_ / nk2_) * 64; } while (0)
#define P0_LOAD() do { _Pragma("unroll") for (int i_ = 0; i_ < 4; ++i_) { const int kk_ = (tid >> 4) + 32 * i_; \
        v[i_] = __builtin_nontemporal_load((const f32x4*)(src + (size_t)(k0 + kk_) * N + n0 + (tid & 15) * 4)); sc[i_] = scale ? scale[k0 + kk_] : 1.0f; } } while (0)
    f32x4 v[4]; float sc[4];
    int job = bx, buf = 0;
    if (job < J5) { P0_DECODE(job); P0_LOAD(); }
    __syncthreads();
    while (job < J5) {
        LAS bf16_t* tl = (LAS bf16_t*)(lds + buf * 17408);
        const int nn = (tid & 15) * 4;
#pragma unroll
        for (int i = 0; i < 4; ++i) { const int kk = (tid >> 4) + 32 * i; const unsigned w0 = cvt_pk_bf16(v[i][0] * sc[i], v[i][1] * sc[i]), w1 = cvt_pk_bf16(v[i][2] * sc[i], v[i][3] * sc[i]);
            tl[(nn + 0) * 136 + kk] = (bf16_t)(w0 & 0xffff); tl[(nn + 1) * 136 + kk] = (bf16_t)(w0 >> 16); tl[(nn + 2) * 136 + kk] = (bf16_t)(w1 & 0xffff); tl[(nn + 3) * 136 + kk] = (bf16_t)(w1 >> 16); }
        bf16_t* cdst = dst; const int cK = K, cmode = mode, ck0 = k0, cn0 = n0;
        const int nxt = job + G;
        if (nxt < J5) { P0_DECODE(nxt); P0_LOAD(); }
        __syncthreads();
        { const int n = tid >> 3, kc = (tid & 7) * 16; const LAS unsigned char* rp = lds + buf * 17408 + n * 272 + kc * 2;
          const u32x4 w0 = *(const LAS u32x4*)rp, w1 = *(const LAS u32x4*)(rp + 16);
          int R = cn0 + n;
          if (cmode == 1) { const int j = (R < FF) ? R : R - FF; R = 256 * (j >> 7) + (j & 127) + ((cn0 + n < FF) ? 0 : 128); }
          bf16_t* op = cdst + (size_t)R * cK + ck0 + kc; *(u32x4*)op = w0; *(u32x4*)(op + 8) = w1; }
        job = nxt; buf ^= 1;
    }
#undef P0_DECODE
#undef P0_LOAD
    __syncthreads();
}

__device__ __forceinline__ void attn_softmax(f32x4 (&sc)[4], float& m_run, float& l_run, f32x4 (&o)[8], const int j, const int tq, const int g, const LAS float* tb, bf16x8 (&pb)[2]) {
    const float SC = 0.08838834764831845f * LOG2E;
    float mx = m_run;
    if (j <= 5) { const float bc = tb[256];
#pragma unroll
        for (int mt = 0; mt < 4; ++mt)
#pragma unroll
            for (int e = 0; e < 4; ++e) { sc[mt][e] = sc[mt][e] * SC + bc; mx = fmaxf(mx, sc[mt][e]); } }
    else { const int relb = tq + 64 * (8 - j) - 4 * g;
#pragma unroll
        for (int mt = 0; mt < 4; ++mt)
#pragma unroll
            for (int e = 0; e < 4; ++e) { int rel = relb - 16 * mt - e; rel = rel > 128 ? 128 : rel; sc[mt][e] = sc[mt][e] * SC + tb[rel + 128]; mx = fmaxf(mx, sc[mt][e]); } }
    mx = fmaxf(mx, __shfl_xor(mx, 16)); mx = fmaxf(mx, __shfl_xor(mx, 32));
    const float alpha = __builtin_amdgcn_exp2f(m_run - mx); m_run = mx;
    float ls = 0.f;
#pragma unroll
    for (int mt = 0; mt < 4; ++mt)
#pragma unroll
        for (int e = 0; e < 4; ++e) { sc[mt][e] = __builtin_amdgcn_exp2f(sc[mt][e] - mx); ls += sc[mt][e]; }
    l_run = l_run * alpha + ls;
    if (__builtin_amdgcn_ballot_w64(alpha != 1.0f) != 0ull) {
#pragma unroll
        for (int cc = 0; cc < 8; ++cc) o[cc] *= alpha;
    }
#pragma unroll
    for (int s2 = 0; s2 < 2; ++s2) { u32x4 pw; pw.x = cvt_pk_bf16(sc[2 * s2][0], sc[2 * s2][1]); pw.y = cvt_pk_bf16(sc[2 * s2][2], sc[2 * s2][3]);
        pw.z = cvt_pk_bf16(sc[2 * s2 + 1][0], sc[2 * s2 + 1][1]); pw.w = cvt_pk_bf16(sc[2 * s2 + 1][2], sc[2 * s2 + 1][3]); pb[s2] = __builtin_bit_cast(bf16x8, pw); }
}
__device__ void attn_quad(const bf16_t* proj, const float* rel_bias, bf16_t* ycat, int quad, LAS unsigned char* lds, const int WID) {
    const int tid = TID_X, grp = WID >> 2, wq = WID & 3, lane = tid & 63, g = lane >> 4, li = lane & 15;
    const int bh = quad >> 4, c0 = (quad & 15) * 4, h = bh & 7, b = bh >> 3;
    const int kA = 2 * grp, kB = kA + 1;
    const int tokq = b * SEQ + c0 * 64;
    LAS float* tb = (LAS float*)(lds + 65536);
    __syncthreads();
    for (int i = tid; i < 257; i += 512) tb[i] = rel_bias[h * 257 + i] * LOG2E;
    bf16x8 qfA[4], qfB[4];
    { const int qr = tokq + kA * 64 + 16 * wq + li, qc = 4096 + 128 * h + 8 * g;
#pragma unroll
      for (int ks = 0; ks < 4; ++ks) { qfA[ks] = *(const bf16x8*)(proj + proj_off_fr(qr, qc + 32 * ks)); qfB[ks] = *(const bf16x8*)(proj + proj_off_fr(qr + 64, qc + 32 * ks)); } }
    float mA = -1e30f, lA = 0.f, mB = -1e30f, lB = 0.f; f32x4 oA[8], oB[8];
#pragma unroll
    for (int cc = 0; cc < 8; ++cc) { oA[cc] = (f32x4){0.f, 0.f, 0.f, 0.f}; oB[cc] = (f32x4){0.f, 0.f, 0.f, 0.f}; }
    const int u0 = (8 - c0) > 0 ? (8 - c0) : 0;
    const int srow = 16 * (WID & 3) + (tid & 15), sch = 4 * (WID >> 2) + ((tid >> 4) & 3);
    u32x4 kr0[2], vr0[2], kr1[2], vr1[2];
    const bf16_t* kb0 = proj + proj_off_fr(tokq - 512 + srow, 5120 + 128 * h + 8 * sch); const bf16_t* vb0 = proj + proj_off_fr(tokq - 512 + srow, 6144 + 128 * h + 8 * sch);
#define ATT_LOAD(u_, KR, VR) do { const long _o = (long)((u_) >> 2) * (28L << 16) + ((u_) & 1) * 32768 + (((u_) >> 1) & 1) * 4096; _Pragma("unroll") for (int _i = 0; _i < 2; ++_i) { \
        KR[_i] = *(const u32x4*)(kb0 + _o + _i * 16384); VR[_i] = *(const u32x4*)(vb0 + _o + _i * 16384); } } while (0)
#define ATT_STORE(buf_, KR, VR) do { _Pragma("unroll") for (int _i = 0; _i < 2; ++_i) { const unsigned ob_ = off_b(srow, sch + 8 * _i); \
        *(LAS u32x4*)(lds + (buf_) * 32768 + ob_) = KR[_i]; *(LAS u32x4*)(lds + (buf_) * 32768 + 16384 + ob_) = VR[_i]; } } while (0)
    const int tq = 16 * wq + li;
    const unsigned trq = (unsigned)(li >> 2), trp = (unsigned)(li & 3);
#define ATT_COMPUTE(u) do { \
        LAS unsigned char* Kimg = lds + buf * 32768; LAS unsigned char* Vimg = Kimg + 16384; \
        const bool actA = ((u) >= kA) && ((u) <= kA + 8), actB = ((u) >= kB) && ((u) <= kB + 8); \
        if (actA || actB) { \
            f32x4 sA[4], sB[4]; \
            _Pragma("unroll") for (int mt = 0; mt < 4; ++mt) { sA[mt] = (f32x4){0.f, 0.f, 0.f, 0.f}; sB[mt] = (f32x4){0.f, 0.f, 0.f, 0.f}; \
                _Pragma("unroll") for (int ks = 0; ks < 4; ++ks) { const bf16x8 a = *(const LAS bf16x8*)(Kimg + off_b(16 * mt + li, 4 * ks + g)); \
                    if (actA) sA[mt] = __builtin_amdgcn_mfma_f32_16x16x32_bf16(a, qfA[ks], sA[mt], 0, 0, 0); \
                    if (actB) sB[mt] = __builtin_amdgcn_mfma_f32_16x16x32_bf16(a, qfB[ks], sB[mt], 0, 0, 0); } } \
            bf16x8 pbA[2], pbB[2]; \
            pbA[0] = pbA[1] = pbB[0] = pbB[1] = (bf16x8){0, 0, 0, 0, 0, 0, 0, 0}; \
            if (actA) attn_softmax(sA, mA, lA, oA, (u) - kA, tq, g, tb, pbA); \
            if (actB) attn_softmax(sB, mB, lB, oB, (u) - kB, tq, g, tb, pbB); \
            _Pragma("unroll") for (int s2 = 0; s2 < 2; ++s2) { const unsigned r0 = 32 * s2 + 4 * g + trq, r1 = r0 + 16; \
                _Pragma("unroll") for (int cc = 0; cc < 8; ++cc) { \
                    const s16x4 lo = tr_read(Vimg + off_b(r0, 2 * cc + (trp >> 1)) + 8 * (trp & 1)), hi = tr_read(Vimg + off_b(r1, 2 * cc + (trp >> 1)) + 8 * (trp & 1)); \
                    const bf16x8 vf = cat8(lo, hi); \
                    if (actA) oA[cc] = __builtin_amdgcn_mfma_f32_16x16x32_bf16(vf, pbA[s2], oA[cc], 0, 0, 0); \
                    if (actB) oB[cc] = __builtin_amdgcn_mfma_f32_16x16x32_bf16(vf, pbB[s2], oB[cc], 0, 0, 0); \
                } } \
        } } while (0)
    ATT_LOAD(u0, kr0, vr0); ATT_LOAD(u0 + 1, kr1, vr1); ATT_STORE(0, kr0, vr0);
    __syncthreads();
    int buf = 0;
    for (int u = u0; u < 12; u += 2) {
        if (u + 2 < 12) ATT_LOAD(u + 2, kr0, vr0);
        ATT_COMPUTE(u);
        ATT_STORE(buf ^ 1, kr1, vr1);
        __syncthreads(); buf ^= 1;
        if (u + 3 < 12) ATT_LOAD(u + 3, kr1, vr1);
        ATT_COMPUTE(u + 1);
        if (u + 2 < 12) ATT_STORE(buf ^ 1, kr0, vr0);
        __syncthreads(); buf ^= 1;
    }
#undef ATT_COMPUTE
#undef ATT_LOAD
#undef ATT_STORE
    lA += __shfl_xor(lA, 16); lA += __shfl_xor(lA, 32); lB += __shfl_xor(lB, 16); lB += __shfl_xor(lB, 32);
    const float invA = 1.0f / lA, invB = 1.0f / lB;
    bf16_t* yp = ycat + (size_t)(tokq + kA * 64 + tq) * DM + 1024 + 128 * h + 4 * g;
#pragma unroll
    for (int cc = 0; cc < 8; ++cc) { u32x2 w; w.x = cvt_pk_bf16(oA[cc][0] * invA, oA[cc][1] * invA); w.y = cvt_pk_bf16(oA[cc][2] * invA, oA[cc][3] * invA); *(u32x2*)(yp + 16 * cc) = w;
        u32x2 w2; w2.x = cvt_pk_bf16(oB[cc][0] * invB, oB[cc][1] * invB); w2.y = cvt_pk_bf16(oB[cc][2] * invB, oB[cc][3] * invB); *(u32x2*)(yp + (size_t)64 * DM + 16 * cc) = w2; }
}

constexpr int HG_K = 0, HG_V = 16384, HG_Q1 = 32768, HG_Q2 = 49152, HG_S = 65536, HG_TOT = 98304, HG_RED = 102400;

__device__ void hgrn_state_loop(const bf16_t* proj, const float* lbl, float* ust, float* ddec, int task, const int stride, const int ntask, LAS unsigned char* lds, const int WID) {
    const int wid = WID, lane = lane_id_(), tid = wid * 64 + lane, g = lane >> 4, li = lane & 15;
    const int dp = tid & 63, sq = tid >> 6, d0 = 2 * dp;
    LAS float* tot = (LAS float*)(lds + HG_TOT);
    const unsigned trq = (unsigned)(li >> 2), trp = (unsigned)(li & 3);
    const int vrow = 16 * (wid & 3) + li, vch = 4 * (wid >> 2) + g;
    unsigned fw[8]; u32x4 vr[2]; float lbv[4];
#define H1_LOAD(task_) do { const int c_ = (task_) & 63, bh_ = (task_) >> 6, h_ = bh_ & 7, b_ = bh_ >> 3; const int tok_ = b_ * SEQ + c_ * 64; \
        lbv[0] = lbl[128 * h_ + d0]; lbv[1] = lbl[128 * h_ + d0 + 1]; lbv[2] = lbl[1024 + 128 * h_ + d0]; lbv[3] = lbl[1024 + 128 * h_ + d0 + 1]; \
        { const bf16_t* fb_ = proj + proj_off_rm(tok_ + 8 * sq, 1024 + 128 * h_ + d0); _Pragma("unroll") for (int i_ = 0; i_ < 8; ++i_) fw[i_] = *(const unsigned*)(fb_ + i_ * 256); } \
        { const bf16_t* vb_ = proj + proj_off_fr(tok_ + vrow, 2048 + 128 * h_ + 8 * vch); _Pragma("unroll") for (int i_ = 0; i_ < 2; ++i_) vr[i_] = *(const u32x4*)(vb_ + i_ * 16384); } } while (0)
    if (task < ntask) H1_LOAD(task);
    while (task < ntask) {
        const int c = task & 63, bh = task >> 6;
        const int ci = bh * 64 + c;
        __syncthreads();
        float lb[2];
        lb[0] = __builtin_amdgcn_rcpf(1.0f + __expf(lbv[2] - lbv[0])); lb[1] = __builtin_amdgcn_rcpf(1.0f + __expf(lbv[3] - lbv[1]));
        float cs[8][2], kg[8][2];
        { float run0 = 0.f, run1 = 0.f;
#pragma unroll
          for (int i = 0; i < 8; ++i) { const unsigned w = fw[i];
              const float s0 = sigmoidf_(bflo(w)), s1 = sigmoidf_(bfhi(w));
              run0 += __logf(lb[0] + (1.0f - lb[0]) * s0); run1 += __logf(lb[1] + (1.0f - lb[1]) * s1);
              cs[i][0] = run0; cs[i][1] = run1; kg[i][0] = (1.0f - lb[0]) * (1.0f - s0); kg[i][1] = (1.0f - lb[1]) * (1.0f - s1); }
          tot[sq * 128 + d0] = run0; tot[sq * 128 + d0 + 1] = run1; }
#pragma unroll
        for (int i = 0; i < 2; ++i) *(LAS u32x4*)(lds + HG_V + off_b(vrow, vch + 8 * i)) = vr[i];
        const int nxt = task + stride;
        if (nxt < ntask) H1_LOAD(nxt);
        __syncthreads();
        float pre0 = 0.f, pre1 = 0.f, bl0 = 0.f, bl1 = 0.f;
#pragma unroll
        for (int q = 0; q < 8; ++q) { const float t0 = tot[q * 128 + d0], t1 = tot[q * 128 + d0 + 1]; if (q < sq) { pre0 += t0; pre1 += t1; } bl0 += t0; bl1 += t1; }
#pragma unroll
        for (int i = 0; i < 8; ++i) { const int s_ = 8 * sq + i; const float k0 = kg[i][0] * __expf(bl0 - (pre0 + cs[i][0])), k1 = kg[i][1] * __expf(bl1 - (pre1 + cs[i][1]));
            *(LAS unsigned*)(lds + HG_K + off_b(s_, dp >> 2) + (dp & 3) * 4) = cvt_pk_bf16(k0, k1); }
        if (sq == 0) { f32x2 dv; dv.x = __expf(bl0); dv.y = __expf(bl1); *(f32x2*)(ddec + (size_t)ci * 128 + d0) = dv; }
        __syncthreads();
        f32x4 acc[8];
#pragma unroll
        for (int nt = 0; nt < 8; ++nt) acc[nt] = (f32x4){0.f, 0.f, 0.f, 0.f};
#pragma unroll
        for (int ks = 0; ks < 2; ++ks) {
            const unsigned r0 = 32 * ks + 8 * g + trq, r1 = r0 + 4;
            const bf16x8 a = cat8(tr_read(lds + HG_K + off_b(r0, 2 * wid + (trp >> 1)) + 8 * (trp & 1)), tr_read(lds + HG_K + off_b(r1, 2 * wid + (trp >> 1)) + 8 * (trp & 1)));
#pragma unroll
            for (int nt = 0; nt < 8; ++nt) {
                const bf16x8 bb = cat8(tr_read(lds + HG_V + off_b(r0, 2 * nt + (trp >> 1)) + 8 * (trp & 1)), tr_read(lds + HG_V + off_b(r1, 2 * nt + (trp >> 1)) + 8 * (trp & 1)));
                acc[nt] = __builtin_amdgcn_mfma_f32_16x16x32_bf16(a, bb, acc[nt], 0, 0, 0);
            }
        }
        bf16_t* up = (bf16_t*)ust + (size_t)ci * 16384 + 16 * wid + 4 * g;
#pragma unroll
        for (int nt = 0; nt < 8; ++nt) { u32x2 w; w.x = cvt_pk_bf16(acc[nt][0], acc[nt][1]); w.y = cvt_pk_bf16(acc[nt][2], acc[nt][3]); *(u32x2*)(up + (size_t)(16 * nt + li) * 128) = w; }
        task = nxt;
    }
#undef H1_LOAD
}

__device__ void hgrn_scan(const float* ust, const float* ddec, bf16_t* sst, const int WID) {
    for (int e4 = blockIdx.x * 512 + TID_X; e4 < 32 * 4096; e4 += gridDim.x * 512) {
        const int bh = e4 >> 12, off = (e4 & 4095) * 4, d = off & 127;
        f32x4 S = (f32x4){0.f, 0.f, 0.f, 0.f};
        const bf16_t* up = (const bf16_t*)ust + (size_t)bh * 64 * 16384 + off; const float* dp = ddec + (size_t)bh * 64 * 128 + d; bf16_t* sp = sst + (size_t)bh * 64 * 16384 + off;
#pragma unroll 16
        for (int c = 0; c < 64; ++c) {
            const u32x2 uw = *(const u32x2*)(up + (size_t)c * 16384); const f32x4 U = (f32x4){bflo(uw.x), bfhi(uw.x), bflo(uw.y), bfhi(uw.y)}; const f32x4 Dv = *(const f32x4*)(dp + c * 128);
            u32x2 w; w.x = cvt_pk_bf16(S[0], S[1]); w.y = cvt_pk_bf16(S[2], S[3]); *(u32x2*)(sp + (size_t)c * 16384) = w;
            S = Dv * S + U;
        }
    }
}

__device__ void hgrn_out_loop(const bf16_t* proj, const float* lbl, const bf16_t* sst, const float* hgn, bf16_t* ycat, int task, const int stride, const int ntask, LAS unsigned char* lds, const int WID) {
    const int wid = WID, lane = lane_id_(), tid = wid * 64 + lane, g = lane >> 4, li = lane & 15;
    const int dp = tid & 63, sq = tid >> 6, d0 = 2 * dp;
    const int nt = wid & 3, vh = wid >> 2, tloc = 16 * nt + li;
    LAS float* tot = (LAS float*)(lds + HG_TOT);
    LAS float* red = (LAS float*)(lds + HG_RED);
    const unsigned trq = (unsigned)(li >> 2), trp = (unsigned)(li & 3);
    const int vrow = 16 * (wid & 3) + li, vch = 4 * (wid >> 2) + g;
    f32x4 nv[4];
#pragma unroll
    for (int vt = 0; vt < 4; ++vt) nv[vt] = *(const f32x4*)(hgn + 16 * (4 * vh + vt) + 4 * g);
    unsigned fw[8], qw[8]; u32x4 vr[2], sr[4]; u32x2 gw[4], gwn[4]; float lbv[4];
#define H3_LOAD(task_, GW) do { const int c_ = (task_) & 63, bh_ = (task_) >> 6, h_ = bh_ & 7, b_ = bh_ >> 3; const int tok_ = b_ * SEQ + c_ * 64; const size_t ci_ = (size_t)(bh_ * 64 + c_); \
        lbv[0] = lbl[128 * h_ + d0]; lbv[1] = lbl[128 * h_ + d0 + 1]; lbv[2] = lbl[1024 + 128 * h_ + d0]; lbv[3] = lbl[1024 + 128 * h_ + d0 + 1]; \
        { const bf16_t* qb_ = proj + proj_off_rm(tok_ + 8 * sq, 128 * h_ + d0); _Pragma("unroll") for (int i_ = 0; i_ < 8; ++i_) { fw[i_] = *(const unsigned*)(qb_ + (4L << 16) + i_ * 256); qw[i_] = *(const unsigned*)(qb_ + i_ * 256); } } \
        { const bf16_t* vb_ = proj + proj_off_fr(tok_ + vrow, 2048 + 128 * h_ + 8 * vch); _Pragma("unroll") for (int i_ = 0; i_ < 2; ++i_) vr[i_] = *(const u32x4*)(vb_ + i_ * 16384); } \
        _Pragma("unroll") for (int i_ = 0; i_ < 4; ++i_) { const int n_ = tid + 512 * i_; sr[i_] = *(const u32x4*)(sst + ci_ * 16384 + (n_ >> 4) * 128 + 8 * (n_ & 15)); } \
        { const bf16_t* gb_ = proj + proj_off_fr(tok_ + tloc, 3072 + 128 * h_ + 4 * g + 64 * vh); _Pragma("unroll") for (int vt_ = 0; vt_ < 4; ++vt_) GW[vt_] = *(const u32x2*)(gb_ + (vt_ & 1) * 256 + (vt_ >> 1) * 8192); } } while (0)
    if (task < ntask) H3_LOAD(task, gw);
    while (task < ntask) {
        const int c = task & 63, bh = task >> 6, h = bh & 7, b = bh >> 3;
        const int tok0 = b * SEQ + c * 64;
        __syncthreads();
        float lb[2];
        lb[0] = __builtin_amdgcn_rcpf(1.0f + __expf(lbv[2] - lbv[0])); lb[1] = __builtin_amdgcn_rcpf(1.0f + __expf(lbv[3] - lbv[1]));
        float cs[8][2], kg[8][2], qs[8][2];
        { float run0 = 0.f, run1 = 0.f;
#pragma unroll
          for (int i = 0; i < 8; ++i) { const unsigned w = fw[i], wq_ = qw[i];
              const float s0 = sigmoidf_(bflo(w)), s1 = sigmoidf_(bfhi(w));
              run0 += __logf(lb[0] + (1.0f - lb[0]) * s0); run1 += __logf(lb[1] + (1.0f - lb[1]) * s1);
              cs[i][0] = run0; cs[i][1] = run1; kg[i][0] = (1.0f - lb[0]) * (1.0f - s0); kg[i][1] = (1.0f - lb[1]) * (1.0f - s1);
              const float q0 = bflo(wq_), q1 = bfhi(wq_); qs[i][0] = q0 * sigmoidf_(q0); qs[i][1] = q1 * sigmoidf_(q1); }
          tot[sq * 128 + d0] = run0; tot[sq * 128 + d0 + 1] = run1; }
#pragma unroll
        for (int i = 0; i < 2; ++i) *(LAS u32x4*)(lds + HG_V + off_b(vrow, vch + 8 * i)) = vr[i];
#pragma unroll
        for (int i = 0; i < 4; ++i) { const int n = tid + 512 * i; *(LAS u32x4*)(lds + HG_S + off_b(n >> 4, n & 15)) = sr[i]; }
        __syncthreads();
        { float pre0 = 0.f, pre1 = 0.f, bm0 = 0.f, bm1 = 0.f;
#pragma unroll
          for (int q = 0; q < 8; ++q) { const float t0 = tot[q * 128 + d0], t1 = tot[q * 128 + d0 + 1]; if (q < sq) { pre0 += t0; pre1 += t1; } if (q < 4) { bm0 += t0; bm1 += t1; } }
#pragma unroll
          for (int i = 0; i < 8; ++i) { const int s_ = 8 * sq + i; const float b0 = pre0 + cs[i][0], b1 = pre1 + cs[i][1];
              const unsigned o_ = off_b(s_, dp >> 2) + (dp & 3) * 4;
              *(LAS unsigned*)(lds + HG_K + o_) = cvt_pk_bf16(kg[i][0] * __expf(bm0 - b0), kg[i][1] * __expf(bm1 - b1));
              *(LAS unsigned*)(lds + HG_Q1 + o_) = cvt_pk_bf16(qs[i][0] * __expf(b0 - bm0), qs[i][1] * __expf(b1 - bm1));
              *(LAS unsigned*)(lds + HG_Q2 + o_) = cvt_pk_bf16(qs[i][0] * __expf(b0), qs[i][1] * __expf(b1)); } }
        const int nxt = task + stride;
        if (nxt < ntask) H3_LOAD(nxt, gwn);
        __syncthreads();
        bf16x8 q1f[4], q2f[4];
#pragma unroll
        for (int ks = 0; ks < 4; ++ks) { q1f[ks] = *(const LAS bf16x8*)(lds + HG_Q1 + off_b(16 * nt + li, 4 * ks + g)); q2f[ks] = *(const LAS bf16x8*)(lds + HG_Q2 + off_b(16 * nt + li, 4 * ks + g)); }
        f32x4 sc[4];
#pragma unroll
        for (int mt = 0; mt < 4; ++mt) { sc[mt] = (f32x4){0.f, 0.f, 0.f, 0.f};
            if (mt <= nt) {
#pragma unroll
                for (int ks = 0; ks < 4; ++ks) { const bf16x8 a = *(const LAS bf16x8*)(lds + HG_K + off_b(16 * mt + li, 4 * ks + g)); sc[mt] = __builtin_amdgcn_mfma_f32_16x16x32_bf16(a, q1f[ks], sc[mt], 0, 0, 0); }
#pragma unroll
                for (int e = 0; e < 4; ++e) { const int s_ = 16 * mt + 4 * g + e; sc[mt][e] = (s_ <= tloc) ? sc[mt][e] : 0.f; }
            } }
        bf16x8 pb[2];
#pragma unroll
        for (int s2 = 0; s2 < 2; ++s2) { u32x4 pw; pw.x = cvt_pk_bf16(sc[2 * s2][0], sc[2 * s2][1]); pw.y = cvt_pk_bf16(sc[2 * s2][2], sc[2 * s2][3]);
            pw.z = cvt_pk_bf16(sc[2 * s2 + 1][0], sc[2 * s2 + 1][1]); pw.w = cvt_pk_bf16(sc[2 * s2 + 1][2], sc[2 * s2 + 1][3]); pb[s2] = __builtin_bit_cast(bf16x8, pw); }
        f32x4 o[4];
#pragma unroll
        for (int vt = 0; vt < 4; ++vt) { o[vt] = (f32x4){0.f, 0.f, 0.f, 0.f}; const int vtile = 4 * vh + vt;
#pragma unroll
            for (int ks = 0; ks < 4; ++ks) { const bf16x8 a = *(const LAS bf16x8*)(lds + HG_S + off_b(16 * vtile + li, 4 * ks + g)); o[vt] = __builtin_amdgcn_mfma_f32_16x16x32_bf16(a, q2f[ks], o[vt], 0, 0, 0); }
#pragma unroll
            for (int s2 = 0; s2 < 2; ++s2) { const unsigned r0 = 32 * s2 + 4 * g + trq, r1 = r0 + 16;
                const bf16x8 a = cat8(tr_read(lds + HG_V + off_b(r0, 2 * vtile + (trp >> 1)) + 8 * (trp & 1)), tr_read(lds + HG_V + off_b(r1, 2 * vtile + (trp >> 1)) + 8 * (trp & 1)));
                o[vt] = __builtin_amdgcn_mfma_f32_16x16x32_bf16(a, pb[s2], o[vt], 0, 0, 0); }
        }
        float ss = 0.f;
#pragma unroll
        for (int vt = 0; vt < 4; ++vt) ss += (o[vt][0] * o[vt][0] + o[vt][1] * o[vt][1]) + (o[vt][2] * o[vt][2] + o[vt][3] * o[vt][3]);
        ss += __shfl_xor(ss, 16); ss += __shfl_xor(ss, 32);
        if (g == 0) red[wid * 16 + li] = ss;
        __syncthreads();
        const float tot2 = red[wid * 16 + li] + red[(wid ^ 4) * 16 + li];
        const float rstd = rsqrtf(tot2 * (1.0f / 128.0f) + EPS);
        bf16_t* yp = ycat + (size_t)(tok0 + tloc) * DM + 128 * h + 4 * g;
#pragma unroll
        for (int vt = 0; vt < 4; ++vt) { const int v0 = 16 * (4 * vh + vt); const u32x2 gwv = gw[vt];
            const float g0 = bflo(gwv.x), g1 = bfhi(gwv.x), g2 = bflo(gwv.y), g3 = bfhi(gwv.y);
            u32x2 w; w.x = cvt_pk_bf16(o[vt][0] * rstd * nv[vt][0] * g0 * sigmoidf_(g0), o[vt][1] * rstd * nv[vt][1] * g1 * sigmoidf_(g1));
            w.y = cvt_pk_bf16(o[vt][2] * rstd * nv[vt][2] * g2 * sigmoidf_(g2), o[vt][3] * rstd * nv[vt][3] * g3 * sigmoidf_(g3));
            *(u32x2*)(yp + v0) = w; }
#pragma unroll
        for (int vt = 0; vt < 4; ++vt) gw[vt] = gwn[vt];
        task = nxt;
    }
#undef H3_LOAD
}

__device__ void conv_fixup(const float* uedge, const float* cw, const float* cb, bf16_t* act, int pm, const int WID) {
    const bool hp = (pm & 15) != 0;
    const float* e = uedge + (size_t)pm * 4 * FF2; const float* ep = uedge + (size_t)(pm - 1) * 4 * FF2;
    for (int idx = TID_X; idx < 2 * FF; idx += 512) {
        const int r = idx / FF, j = idx - r * FF; const int cg_ = 256 * (j >> 7) + (j & 127);
        float uc[2];
#pragma unroll
        for (int bj = 0; bj < 2; ++bj) { const int cc = cg_ + 128 * bj, no = j + FF * bj;
            const float u0 = e[cc], u1 = e[FF2 + cc];
            const float p254 = hp ? ep[2 * FF2 + cc] : 0.f, p255 = hp ? ep[3 * FF2 + cc] : 0.f;
            const float c0 = cw[no], c1 = cw[FF2 + no], c2 = cw[2 * FF2 + no], bb = cb[no];
            uc[bj] = (r == 0) ? (bb + c2 * u0 + c1 * p255 + c0 * p254) : (bb + c2 * u1 + c1 * u0 + c0 * p255); }
        const float a = uc[0] * sigmoidf_(uc[0]) * uc[1];
        act[(size_t)(pm * 256 + r) * FF + j] = (bf16_t)(cvt_pk_bf16(a, 0.f) & 0xffff);
    }
}

#ifndef REP_P0
#define REP_P0 1
#endif
#ifndef REP_ATT
#define REP_ATT 1
#endif
#ifndef REP_H1
#define REP_H1 1
#endif
#ifndef REP_H2
#define REP_H2 1
#endif
#ifndef REP_H3
#define REP_H3 1
#endif
#ifndef REP_G1
#define REP_G1 1
#endif
#ifndef REP_G2
#define REP_G2 1
#endif
#ifndef REP_GPP
#define REP_GPP 1
#endif
#ifndef REP_G3
#define REP_G3 1
#endif
#ifndef REP_DUMMY
#define REP_DUMMY 0
#endif
#ifndef REP_SYNC
#define REP_SYNC 1
#endif
#define GSYNC() do { for (int s_ = 0; s_ < REP_SYNC; ++s_) xcd_barrier(xb, WID); } while (0)
__global__ void __launch_bounds__(512) mega(Params p) {
    extern __shared__ __attribute__((aligned(16))) unsigned char lds_raw[];
    LAS unsigned char* lds = (LAS unsigned char*)lds_raw;
    cg::grid_group grid = cg::this_grid();
    unsigned char* ws = p.ws;
    const int G = gridDim.x, bx = blockIdx.x;
    const int WID = __builtin_amdgcn_readfirstlane(threadIdx.x >> 6);
    volatile LAS unsigned* stw = (volatile LAS unsigned*)(lds + LDS_BYTES - 16);
    XcdBarrier xb; xb.bar = (unsigned*)(ws + WS_BAR); xb.x = xb_xcc_id(); xb.st = stw;
    if (threadIdx.x == 0) { stw[0] = 0u; stw[1] = 0u; stw[2] = xb_add(&xb.bar[XB_XCNT(xb.x)], 1u); stw[3] = 0u; }
    bf16_t* proj = (bf16_t*)(ws + WS_PROJ); bf16_t* ycat = (bf16_t*)(ws + WS_YCAT);

    for (int r_ = 0; r_ < REP_P0; ++r_) phase0(p, lds, WID);
    grid.sync();
    if (WID == 0 && lane_id_() == 0) { bool uni = (G == 256);
        for (int j = 0; j < 16; ++j) { const unsigned cnt = xb_ld(&xb.bar[XB_XCNT(j)]); uni = uni && (cnt == (j < 8 ? 32u : 0u)); }
        stw[3] = uni ? 1u : 0u; }
    __syncthreads();
    const bool uni_ = __builtin_amdgcn_readfirstlane((int)stw[3]) != 0; const int rank_ = __builtin_amdgcn_readfirstlane((int)stw[2]);
    const int cg_ = uni_ ? (rank_ * 8 + (int)xb.x) : bx, cl_ = uni_ ? ((int)xb.x * 32 + rank_) : bx;
    { pg8::Gemm g{(const bf16_t*)(ws + WS_XA), (const bf16_t*)(ws + WS_WIN), MTOK, INC, DM}; pg8::StaticOrder S; S.init(MTOK, INC, G, cg_);
      pg8::EpiPlainBf16 E{proj, INC, INC / 256}; for (int r_ = 0; r_ < REP_G1; ++r_) pg8::gemm_phase(WID, lds, g, S, E);
      pg8::EpiDummy ED{p.out}; for (int r_ = 0; r_ < REP_DUMMY; ++r_) pg8::gemm_phase<pg8::EpiDummy, true>(WID, lds, g, S, ED); }
    GSYNC();
    for (int r_ = 0; r_ < REP_H1; ++r_)
    hgrn_state_loop(proj, p.in[4], p.out, (float*)(ws + WS_DDEC), cl_, G, 2048, lds, WID);
    GSYNC();
    for (int st = 0; st < 2; ++st) {
        if ((st == 0) == ((cl_ & 1) == 0)) {
            for (int r_ = 0; r_ < REP_ATT; ++r_)
            for (int q = cl_; q < 512; q += G) attn_quad(proj, p.in[6], ycat, q, lds, WID);
        } else {
            for (int r_ = 0; r_ < REP_H2; ++r_)
            hgrn_scan(p.out, (const float*)(ws + WS_DDEC), (bf16_t*)(ws + WS_SST), WID);
        }
    }
    GSYNC();
    for (int r_ = 0; r_ < REP_H3; ++r_)
    hgrn_out_loop(proj, p.in[4], (const bf16_t*)(ws + WS_SST), p.in[5], ycat, cl_, G, 2048, lds, WID);
    GSYNC();
    { pg8::Gemm g{ycat, (const bf16_t*)(ws + WS_WOUT), MTOK, DM, DM}; pg8::StaticOrder S; S.init(MTOK, DM, G, cg_);
      pg8::EpiResid<false> E{p.in[0], (bf16_t*)(ws + WS_H1B), (float*)(ws + WS_SSQ1)}; for (int r_ = 0; r_ < REP_G2; ++r_) pg8::gemm_phase(WID, lds, g, S, E); }
    { pg8::Gemm g{(const bf16_t*)(ws + WS_PB), (const bf16_t*)(ws + WS_WPROJ), MTOK, DM, PLE}; pg8::StaticOrder S; S.init(MTOK, DM, G, cg_);
      pg8::EpiPlainBf16 E{(bf16_t*)(ws + WS_PP), DM, DM / 256, 0};     for (int r_ = 0; r_ < REP_GPP; ++r_) pg8::gemm_phase(WID, lds, g, S, E); }
    GSYNC();
    { pg8::Gemm g{(const bf16_t*)(ws + WS_H1B), (const bf16_t*)(ws + WS_WUP), MTOK, FF2, DM}; pg8::StaticOrder S; S.init(MTOK, FF2, G, cg_);
      pg8::EpiConv E{(const float*)(ws + WS_SSQ1), p.in[10], p.in[11], (bf16_t*)(ws + WS_ACT), (float*)(ws + WS_UEDGE), (LAS float*)(lds + pg8::STAGE_BYTES), (LAS float*)(lds + pg8::STAGE_BYTES + 8192), (LAS float*)(lds + pg8::STAGE_BYTES + 16384)};
      if (lane_id_() == 0) ((LAS int*)(lds + pg8::STAGE_BYTES + 16384 + 4096))[WID] = -1;
      __syncthreads();
      for (int r_ = 0; r_ < REP_G3; ++r_) pg8::gemm_phase(WID, lds, g, S, E); }
    GSYNC();
    { pg8::StaticOrder S; S.init(MTOK, DM, G, cg_); pg8::Unit u; int last = -1;
      for (int i = 0; S.next(i, u); ++i) if (u.pm != last) { conv_fixup((const float*)(ws + WS_UEDGE), p.in[10], p.in[11], (bf16_t*)(ws + WS_ACT), u.pm, WID); last = u.pm; }
      __threadfence(); __syncthreads();
      pg8::Gemm g{(const bf16_t*)(ws + WS_ACT), (const bf16_t*)(ws + WS_WDOWN), MTOK, DM, FF};
      pg8::EpiResid<true> E{(const void*)(ws + WS_H1B), (bf16_t*)(ws + WS_H1B), (float*)(ws + WS_SSQ2)}; pg8::gemm_phase(WID, lds, g, S, E); }
    GSYNC();
    { pg8::Gemm g{(const bf16_t*)(ws + WS_H1B), (const bf16_t*)(ws + WS_WGATE), MTOK, DM, DM}; pg8::StaticOrder S; S.init(MTOK, DM, G, cg_);
      pg8::EpiPle E{(const float*)(ws + WS_SSQ2), (const bf16_t*)(ws + WS_PP), (const bf16_t*)(ws + WS_H1B), (bf16_t*)(ws + WS_ACT), (float*)(ws + WS_SSQ3)}; pg8::gemm_phase(WID, lds, g, S, E); }
    GSYNC();
    { const int wid = WID, lane = lane_id_(); const float* fn = p.in[16]; const float* ssq = (const float*)(ws + WS_SSQ3); const bf16_t* h3b = (const bf16_t*)(ws + WS_ACT);
      for (int r = bx * 8 + wid; r < MTOK; r += G * 8) { float* xr = p.out + (size_t)r * DM; const bf16_t* hr = h3b + (size_t)r * DM;
          u32x4 hv[4];
#pragma unroll
          for (int i = 0; i < 4; ++i) hv[i] = *(const u32x4*)(hr + i * 512 + lane * 8);
          float s = (lane < 32) ? ssq[(size_t)r * 32 + lane] : 0.f;
#pragma unroll
          for (int o = 32; o >= 1; o >>= 1) s += __shfl_xor(s, o);
          const float rstd = rsqrtf(s * (1.0f / 2048.0f) + EPS);
#pragma unroll
          for (int i = 0; i < 4; ++i) { const f32x4 g0 = *(const f32x4*)(fn + i * 512 + lane * 8), g1 = *(const f32x4*)(fn + i * 512 + lane * 8 + 4);
              f32x4 a, b2; a[0] = bflo(hv[i].x) * rstd * g0[0]; a[1] = bfhi(hv[i].x) * rstd * g0[1]; a[2] = bflo(hv[i].y) * rstd * g0[2]; a[3] = bfhi(hv[i].y) * rstd * g0[3];
              b2[0] = bflo(hv[i].z) * rstd * g1[0]; b2[1] = bfhi(hv[i].z) * rstd * g1[1]; b2[2] = bflo(hv[i].w) * rstd * g1[2]; b2[3] = bfhi(hv[i].w) * rstd * g1[3];
              __builtin_nontemporal_store(a, (f32x4*)(xr + i * 512 + lane * 8)); __builtin_nontemporal_store(b2, (f32x4*)(xr + i * 512 + lane * 8 + 4)); } } }
}

extern "C" void kernel_launch(void* const* d_in, const int* in_sizes, int n_in, void* d_out, int out_size, void* d_ws, size_t ws_size, hipStream_t stream) {
    static int grid = 0;
    if (grid == 0) {
        if (n_in != 17 || out_size != MTOK * DM || ws_size < WS_END) { fprintf(stderr, "kernel_launch: unexpected shapes (n_in %d out %d ws %zu)\n", n_in, out_size, ws_size); grid = -1; return; }
        int dev = 0, cus = 0, per_cu = 0;
        (void)hipGetDevice(&dev);
        (void)hipDeviceGetAttribute(&cus, hipDeviceAttributeMultiprocessorCount, dev);
        if (hipFuncSetAttribute((const void*)mega, hipFuncAttributeMaxDynamicSharedMemorySize, LDS_BYTES) != hipSuccess) { fprintf(stderr, "hipFuncSetAttribute failed\n"); grid = -1; return; }
        if (hipOccupancyMaxActiveBlocksPerMultiprocessor(&per_cu, (const void*)mega, 512, LDS_BYTES) != hipSuccess || per_cu < 1) { fprintf(stderr, "occupancy query: %d\n", per_cu); (void)hipGetLastError(); grid = -1; return; }
        grid = cus;
    }
    if (grid < 0) return;
    Params p{};
    for (int i = 0; i < 17; ++i) p.in[i] = (const float*)d_in[i];
    p.out = (float*)d_out; p.ws = (unsigned char*)d_ws;
    void* args[] = {&p};
    if (hipMemsetAsync((unsigned char*)d_ws + WS_BAR, 0, XCD_BAR_WORDS * 4, stream) != hipSuccess) { fprintf(stderr, "memset failed\n"); return; }
    hipError_t e = hipLaunchCooperativeKernel((const void*)mega, dim3(grid), dim3(512), args, LDS_BYTES, stream);
    if (e != hipSuccess) fprintf(stderr, "cooperative launch failed: %s\n", hipGetErrorString(e));
}
```

```cpp
#include <hip/hip_runtime.h>
#include <hip/hip_cooperative_groups.h>
#include <cstdio>
namespace cg = cooperative_groups;

#define LAS __attribute__((address_space(3)))
typedef unsigned short bf16_t;
typedef short bf16x8 __attribute__((ext_vector_type(8)));
typedef short s16x4 __attribute__((ext_vector_type(4)));
typedef float f32x4 __attribute__((ext_vector_type(4)));
typedef float f32x2 __attribute__((ext_vector_type(2)));
typedef unsigned u32x4 __attribute__((ext_vector_type(4)));
typedef unsigned u32x2 __attribute__((ext_vector_type(2)));

constexpr int MTOK = 16384, DM = 2048, INC = 7168, FF = 5632, FF2 = 11264, PLE = 256, SEQ = 4096;
constexpr int LDS_BYTES = 149 * 1024;
constexpr float EPS = 1e-6f;
constexpr float LOG2E = 1.4426950408889634f;

constexpr size_t MiB = 1048576;
constexpr size_t WS_WIN = 0, WS_WOUT = 28 * MiB, WS_WUP = 36 * MiB, WS_WDOWN = 80 * MiB, WS_WGATE = 102 * MiB, WS_WPROJ = 110 * MiB;
constexpr size_t WS_PROJ = 111 * MiB;
constexpr size_t WS_XA = 335 * MiB;
constexpr size_t WS_YCAT = 335 * MiB;
constexpr size_t WS_SST = 399 * MiB;
constexpr size_t WS_DDEC = 463 * MiB;
constexpr size_t WS_SSQ1 = 464 * MiB, WS_SSQ2 = 466 * MiB, WS_SSQ3 = 468 * MiB;
constexpr size_t WS_PB = 470 * MiB;
constexpr size_t WS_H1B = 111 * MiB;
constexpr size_t WS_PP = 175 * MiB;
constexpr size_t WS_ACT = 239 * MiB;
constexpr size_t WS_UEDGE = 415 * MiB;
constexpr size_t WS_BAR = 478 * MiB;
constexpr size_t WS_END = 479 * MiB;

struct Params { const float* in[17]; float* out; unsigned char* ws; };

__device__ __forceinline__ unsigned cvt_pk_bf16(float lo, float hi) { unsigned r; asm volatile("v_cvt_pk_bf16_f32 %0, %1, %2" : "=v"(r) : "v"(lo), "v"(hi)); return r; }
__device__ __forceinline__ float bf2f(unsigned short b) { return __uint_as_float(((unsigned)b) << 16); }
__device__ __forceinline__ float bflo(unsigned w) { return __uint_as_float(w << 16); }
__device__ __forceinline__ float bfhi(unsigned w) { return __uint_as_float(w & 0xffff0000u); }
__device__ __forceinline__ float sigmoidf_(float x) { return __builtin_amdgcn_rcpf(1.0f + __expf(-x)); }
__device__ __forceinline__ size_t proj_off(int row, int col) {
    const int rl = row & 255, cl = col & 255; const size_t tb = (size_t)((row >> 8) * 28 + (col >> 8)) << 16;
    if (col < 2048) return tb + (size_t)((rl << 8) + cl);
    const int wv = ((rl >> 6) & 1) * 4 + ((cl >> 5) & 3), k = (((rl >> 7) & 1) * 4 + ((rl >> 4) & 3)) * 2 + ((cl >> 7) & 1), ln = ((cl >> 3) & 3) * 16 + (rl & 15);
    return tb + (size_t)((((wv * 16 + k) * 64 + ln) << 3) + (cl & 7));
}
__device__ __forceinline__ long proj_off_rm(int row, int col) { return ((long)((row >> 8) * 28 + (col >> 8)) << 16) + (long)(((row & 255) << 8) + (col & 255)); }
__device__ __forceinline__ long proj_off_fr(int row, int col) {
    const int rl = row & 255, cl = col & 255;
    const int wv = ((rl >> 6) & 1) * 4 + ((cl >> 5) & 3), k = (((rl >> 7) & 1) * 4 + ((rl >> 4) & 3)) * 2 + ((cl >> 7) & 1), ln = ((cl >> 3) & 3) * 16 + (rl & 15);
    return ((long)((row >> 8) * 28 + (col >> 8)) << 16) + (long)((((wv * 16 + k) * 64 + ln) << 3) + (cl & 7));
}
__device__ __forceinline__ unsigned off_b(unsigned row, unsigned ch) { return 256u * row + 16u * (ch ^ (((row & 3u) << 2) | ((row >> 2) & 3u))); }
__device__ __forceinline__ s16x4 tr_read(LAS unsigned char* p) { return __builtin_bit_cast(s16x4, __builtin_amdgcn_ds_read_tr16_b64_v4i16((LAS s16x4*)p)); }
__device__ __forceinline__ bf16x8 cat8(s16x4 a, s16x4 b) { return (bf16x8){a[0], a[1], a[2], a[3], b[0], b[1], b[2], b[3]}; }
__device__ __forceinline__ float dpp_ror1(float v) { return __int_as_float(__builtin_amdgcn_update_dpp(0, __float_as_int(v), 0x121, 0xf, 0xf, false)); }
__device__ __forceinline__ float dpp_shr1(float old, float v) { return __int_as_float(__builtin_amdgcn_update_dpp(__float_as_int(old), __float_as_int(v), 0x111, 0xf, 0xf, false)); }
__device__ __forceinline__ float dpp_shr2(float old, float v) { return __int_as_float(__builtin_amdgcn_update_dpp(__float_as_int(old), __float_as_int(v), 0x112, 0xf, 0xf, false)); }
__device__ __forceinline__ float dpp_ror2(float v) { return __int_as_float(__builtin_amdgcn_update_dpp(0, __float_as_int(v), 0x122, 0xf, 0xf, false)); }

__device__ __forceinline__ int lane_id_() { int l; asm volatile("v_mbcnt_lo_u32_b32 %0, -1, 0\n\tv_mbcnt_hi_u32_b32 %0, -1, %0" : "=v"(l)); return l; }
#define TID_X (WID * 64 + lane_id_())

#define XB_TMO      128
#define XB_XCNT(j)  (256  + 64 * (j))
#define XB_XSUB(j)  (1280 + 64 * (j))
#define XB_XGEN(j)  (2304 + 64 * (j))
#define XB_TOP      3328
#define XB_TOPGEN   3392
#define XCD_BAR_WORDS 3456
#define XB_SPIN_CAP (1u << 18)
__device__ __forceinline__ unsigned xb_ld(unsigned* p)              { return __hip_atomic_load(p, __ATOMIC_RELAXED, __HIP_MEMORY_SCOPE_AGENT); }
__device__ __forceinline__ unsigned xb_add(unsigned* p, unsigned v) { return __hip_atomic_fetch_add(p, v, __ATOMIC_RELAXED, __HIP_MEMORY_SCOPE_AGENT); }
__device__ __forceinline__ unsigned xb_xcc_id() { return (unsigned)__builtin_amdgcn_s_getreg((3 << 11) | 20) & 0xFu; }
#define XB_SPIN(cond, bar) do { unsigned _sp = 0; while (cond) { __builtin_amdgcn_s_sleep(1); \
    if ((++_sp & 255u) == 0u) { if (xb_ld(&(bar)[XB_TMO])) break; if (_sp > XB_SPIN_CAP) { atomicAdd(&(bar)[XB_TMO], 1u); break; } } } } while (0)
struct XcdBarrier { unsigned* bar; unsigned x; volatile LAS unsigned* st; };
__device__ __forceinline__ void xcd_barrier_complete(unsigned* bar, unsigned x, unsigned& nloc, unsigned& nx) {
    const unsigned G = gridDim.x;
    unsigned sum, cnt, mine, sp = 0u;
    for (;;) {
        sum = 0u; cnt = 0u; mine = 0u;
#pragma unroll
        for (unsigned j = 0; j < 16; ++j) { const unsigned c = xb_ld(&bar[XB_XCNT(j)]); sum += c; cnt += (c > 0u) ? 1u : 0u; mine = (j == x) ? c : mine; }
        if (sum == G) break;
        __builtin_amdgcn_s_sleep(1);
        if ((++sp & 255u) == 0u) { if (xb_ld(&bar[XB_TMO])) break; if (sp > XB_SPIN_CAP) { atomicAdd(&bar[XB_TMO], 1u); break; } }
    }
    nloc = mine > 0u ? mine : 1u; nx = cnt > 0u ? cnt : 1u;
}
__device__ __forceinline__ void xcd_barrier(const XcdBarrier& b, const int WID) {
    asm volatile("s_waitcnt vmcnt(0)" ::: "memory");
    __syncthreads();
    if (WID == 0 && lane_id_() == 0) {
        unsigned* bar = b.bar;
        __builtin_amdgcn_s_waitcnt(0);
        unsigned nloc = b.st[0], nx = b.st[1];
        if (nloc == 0u) { xcd_barrier_complete(bar, b.x, nloc, nx); b.st[0] = nloc; b.st[1] = nx; }
        const unsigned old = xb_add(&bar[XB_XSUB(b.x)], 1u);
        const unsigned gen = old / nloc;
        if (old + 1u == (gen + 1u) * nloc) {
            __builtin_amdgcn_fence(__ATOMIC_RELEASE, "agent");
            asm volatile("s_waitcnt vmcnt(0)" ::: "memory");
            const unsigned og = xb_add(&bar[XB_TOP], 1u);
            const unsigned tg = og / nx;
            if (og + 1u == (tg + 1u) * nx) xb_add(&bar[XB_TOPGEN], 1u);
            else XB_SPIN(xb_ld(&bar[XB_TOPGEN]) == tg, bar);
            __builtin_amdgcn_fence(__ATOMIC_ACQUIRE, "agent");
            xb_add(&bar[XB_XGEN(b.x)], 1u);
            asm volatile("s_waitcnt vmcnt(0)" ::: "memory");
        } else {
            XB_SPIN(xb_ld(&bar[XB_XGEN(b.x)]) == gen, bar);
            __builtin_amdgcn_fence(__ATOMIC_ACQUIRE, "agent");
            asm volatile("s_waitcnt vmcnt(0)" ::: "memory");
        }
    }
    __syncthreads();
}

namespace pg8 {
constexpr int BM = 256, BK = 64, HALF = 128, HTB = HALF * BK * 2, STAGE_BYTES = 8 * HTB, NXCD = 8, WGM = 8;
__device__ __forceinline__ int lds_byte(int r, int c) { const int st = (r >> 4) * 2 + (c >> 5), rr = r & 15, cc = c & 31, ob = rr * 64 + cc * 2; return st * 1024 + (ob ^ (((ob >> 9) & 1) << 5)); }
__device__ __forceinline__ void stage_rc(int b, int& R, int& C) { const int st = b / 1024, sb = b % 1024, swz = sb ^ (((sb >> 9) & 1) << 5); R = (st >> 1) * 16 + swz / 64; C = (st & 1) * 32 + (swz % 64) / 2; }
__device__ __forceinline__ int perm32(int rho) { const int n = rho >> 4, i = rho & 15; return 8 * (i >> 2) + 4 * n + (i & 3); }
struct Unit { int pm, pn; };
struct Gemm { const bf16_t* A; const bf16_t* Bt; int M, N, K; };
struct StaticOrder {
    int nM, nN, nwg, G, c;
    __device__ void init(int M, int N, int G_, int c_) { nM = M / BM; nN = N / BM; nwg = nM * nN; G = G_; c = c_; }
    __device__ bool next(int i, Unit& u) const {
        const long L = (long)i * G + c; if (L >= nwg) return false;
        int wgid = (int)L; { const int q = nwg / NXCD, r = nwg % NXCD, xcd = wgid % NXCD, off = wgid / NXCD; wgid = (xcd < r ? xcd * (q + 1) : r * (q + 1) + (xcd - r) * q) + off; }
        const int nig = WGM * nN, gid = wgid / nig, fm = gid * WGM, gsz = (nM - fm) < WGM ? (nM - fm) : WGM;
        u.pm = fm + ((wgid % nig) % gsz); u.pn = (wgid % nig) / gsz; return true;
    }
};

template <class Epi, bool KS0 = false>
__device__ __forceinline__ void gemm_phase(const int WID, LAS unsigned char* lds, const Gemm g, const StaticOrder& S, const Epi& E) {
    const int wid = WID, lane = lane_id_(), tid = wid * 64 + lane, wr = wid >> 2, wc = wid & 3, fr = lane & 15, fq = lane >> 4;
    const int K = g.K, nt = K / BK;
    unsigned voffA[2], voffB[2];
#pragma unroll
    for (int i = 0; i < 2; ++i) { int R, C; stage_rc(tid * 16 + i * 8192, R, C); const int Rb = Epi::PERM ? ((R & ~31) + perm32(R & 31)) : R;
        voffA[i] = (unsigned)(R * K + C) * 2u; voffB[i] = (unsigned)(Rb * K + C) * 2u; }
    const size_t kstep = KS0 ? (size_t)0 : (size_t)(BK * 2);
    const size_t hstep = (size_t)HALF * K * 2;
    const size_t tstep = 2 * hstep;
    const unsigned ldsw = (unsigned)wid * 1024u;
    const int aoff = lds_byte(wr * 64 + fr, fq * 8), boff = lds_byte(wc * 32 + fr, fq * 8);
#define PG8_SA(b, h) (((b) * 2 + (h)) * HTB)
#define PG8_SB(b, h) ((4 + (b) * 2 + (h)) * HTB)
#define PG8_STAGE(bufoff, gbase, voff) do { _Pragma("unroll") for (int _i = 0; _i < 2; ++_i) \
        __builtin_amdgcn_global_load_lds((const unsigned*)((const char*)(gbase) + (voff)[_i]), (LAS unsigned*)(lds + (bufoff) + ldsw + _i * 8192), 16, 0, 0); } while (0)
#define PG8_LDA(dst, b, h) do { _Pragma("unroll") for (int m = 0; m < 4; ++m) _Pragma("unroll") for (int k = 0; k < 2; ++k) dst[m][k] = *(const LAS bf16x8*)(lds + PG8_SA(b, h) + aoff + m * 2048 + k * 1024); } while (0)
#define PG8_LDB(dst, b, h) do { _Pragma("unroll") for (int n = 0; n < 2; ++n) _Pragma("unroll") for (int k = 0; k < 2; ++k) dst[n][k] = *(const LAS bf16x8*)(lds + PG8_SB(b, h) + boff + n * 2048 + k * 1024); } while (0)
#define PG8_MMA(ai, bj, At, Bt) do { __builtin_amdgcn_s_setprio(1); _Pragma("unroll") for (int m = 0; m < 4; ++m) _Pragma("unroll") for (int n = 0; n < 2; ++n) _Pragma("unroll") for (int k = 0; k < 2; ++k) \
        acc[ai][bj][m][n] = __builtin_amdgcn_mfma_f32_16x16x32_bf16(Bt[n][k], At[m][k], acc[ai][bj][m][n], 0, 0, 0); __builtin_amdgcn_s_setprio(0); } while (0)
#define PG8_WAIT_V(n) asm volatile("s_waitcnt vmcnt(" #n ")" ::: "memory")
#define PG8_WAIT_L(n) asm volatile("s_waitcnt lgkmcnt(" #n ")" ::: "memory")
#define PG8_BAR __builtin_amdgcn_s_barrier()
#define PG8_SCHED __builtin_amdgcn_sched_barrier(0)
    Unit cur, nxt; int ui = 0;
    if (!S.next(0, cur)) return;
    f32x4 acc[2][2][4][2];
#pragma unroll
    for (int a = 0; a < 2; ++a)
#pragma unroll
        for (int b = 0; b < 2; ++b)
#pragma unroll
            for (int m = 0; m < 4; ++m)
#pragma unroll
                for (int n = 0; n < 2; ++n) acc[a][b][m][n] = (f32x4){0.f, 0.f, 0.f, 0.f};
    bf16x8 At[4][2], B0[2][2], B1[2][2];
    const char* cA = (const char*)g.A + (size_t)cur.pm * tstep; const char* cB = (const char*)g.Bt + (size_t)cur.pn * tstep;
    PG8_STAGE(PG8_SB(0, 0), cB, voffB); PG8_STAGE(PG8_SA(0, 0), cA, voffA); PG8_STAGE(PG8_SB(0, 1), cB + hstep, voffB); PG8_STAGE(PG8_SA(0, 1), cA + hstep, voffA);
    if (wr == 1) PG8_BAR;
    PG8_WAIT_V(4); PG8_BAR;
    PG8_STAGE(PG8_SB(1, 0), cB + kstep, voffB); PG8_STAGE(PG8_SA(1, 0), cA + kstep, voffA); PG8_STAGE(PG8_SB(1, 1), cB + hstep + kstep, voffB);
    PG8_WAIT_V(6); PG8_BAR;
    for (;;) {
        const bool has_next = S.next(ui + 1, nxt);
        const char* nA = has_next ? (const char*)g.A + (size_t)nxt.pm * tstep : cA; const char* nB = has_next ? (const char*)g.Bt + (size_t)nxt.pn * tstep : cB;
        for (int t = 0; t < nt; t += 2) {
            const bool last = (t == nt - 2);
            const char* a1 = cA + (size_t)(t + 1) * kstep;
            const char* a2 = last ? nA : cA + (size_t)(t + 2) * kstep; const char* b2 = last ? nB : cB + (size_t)(t + 2) * kstep;
            const char* a3 = a2 + kstep; const char* b3 = b2 + kstep;
            PG8_LDB(B0, 0, 0); PG8_SCHED; PG8_LDA(At, 0, 0); PG8_STAGE(PG8_SA(1, 1), a1 + hstep, voffA);
            PG8_WAIT_L(8); PG8_BAR; PG8_WAIT_L(0); PG8_MMA(0, 0, At, B0); PG8_BAR; PG8_SCHED;
            PG8_LDB(B1, 0, 1); PG8_STAGE(PG8_SB(0, 0), b2, voffB);
            PG8_BAR; PG8_WAIT_L(0); PG8_MMA(0, 1, At, B1); PG8_BAR;
            PG8_LDA(At, 0, 1); PG8_STAGE(PG8_SA(0, 0), a2, voffA);
            PG8_BAR; PG8_WAIT_L(0); PG8_MMA(1, 0, At, B0); PG8_BAR; PG8_SCHED;
            PG8_STAGE(PG8_SB(0, 1), b2 + hstep, voffB);
            PG8_WAIT_V(6); PG8_BAR; PG8_MMA(1, 1, At, B1); PG8_BAR;
            PG8_LDB(B0, 1, 0); PG8_SCHED; PG8_LDA(At, 1, 0); PG8_STAGE(PG8_SA(0, 1), a2 + hstep, voffA);
            PG8_WAIT_L(8); PG8_BAR; PG8_WAIT_L(0); PG8_MMA(0, 0, At, B0); PG8_BAR; PG8_SCHED;
            PG8_LDB(B1, 1, 1); PG8_STAGE(PG8_SB(1, 0), b3, voffB);
            PG8_BAR; PG8_WAIT_L(0); PG8_MMA(0, 1, At, B1); PG8_BAR;
            PG8_LDA(At, 1, 1); PG8_STAGE(PG8_SA(1, 0), a3, voffA);
            PG8_BAR; PG8_WAIT_L(0); PG8_MMA(1, 0, At, B0); PG8_BAR; PG8_SCHED;
            PG8_STAGE(PG8_SB(1, 1), b3 + hstep, voffB);
            PG8_WAIT_V(6); PG8_BAR; PG8_MMA(1, 1, At, B1); PG8_BAR;
        }
        { int fr2 = lane_id_(), fq2; fq2 = fr2 >> 4; fr2 &= 15; asm volatile("" : "+v"(fr2), "+v"(fq2)); E(acc, cur, wr, wc, fr2, fq2); }
        if (!has_next) break;
#pragma unroll
        for (int a = 0; a < 2; ++a)
#pragma unroll
            for (int b = 0; b < 2; ++b)
#pragma unroll
                for (int m = 0; m < 4; ++m)
#pragma unroll
                    for (int n = 0; n < 2; ++n) acc[a][b][m][n] = (f32x4){0.f, 0.f, 0.f, 0.f};
        cur = nxt; cA = nA; cB = nB; ++ui;
    }
    PG8_WAIT_V(0);
    if (wr == 0) PG8_BAR;
    PG8_BAR;
#undef PG8_SA
#undef PG8_SB
#undef PG8_STAGE
#undef PG8_LDA
#undef PG8_LDB
#undef PG8_MMA
#undef PG8_WAIT_V
#undef PG8_WAIT_L
#undef PG8_SCHED
}

struct EpiPlainBf16 {
    static constexpr bool PERM = true;
    bf16_t* O; int ldc; int frag = 0; int fmin = 8;
    __device__ __forceinline__ void operator()(f32x4 (&acc)[2][2][4][2], const Unit& u, int wr, int wc, int fr, int fq) const {
        bf16_t* base; size_t s_ai, s_m, s_bj;
        if (frag && u.pn >= fmin) { base = O + ((size_t)(u.pm * frag + u.pn) << 16) + (size_t)((((wr * 4 + wc) * 16) * 64 + fq * 16 + fr) << 3); s_ai = 4096; s_m = 1024; s_bj = 512; }
        else if (frag) { base = O + ((size_t)(u.pm * frag + u.pn) << 16) + (size_t)(((wr * 64 + fr) << 8) + wc * 32 + 8 * fq); s_ai = (size_t)HALF * 256; s_m = 16 * 256; s_bj = HALF; }
        else { base = O + (size_t)(u.pm * BM + wr * 64 + fr) * ldc + u.pn * BM + wc * 32 + 8 * fq; s_ai = (size_t)HALF * ldc; s_m = (size_t)16 * ldc; s_bj = HALF; }
#pragma unroll
        for (int ai = 0; ai < 2; ++ai)
#pragma unroll
            for (int m = 0; m < 4; ++m)
#pragma unroll
                for (int bj = 0; bj < 2; ++bj) { const f32x4 v0 = acc[ai][bj][m][0], v1 = acc[ai][bj][m][1];
                    u32x4 w; w.x = cvt_pk_bf16(v0[0], v0[1]); w.y = cvt_pk_bf16(v0[2], v0[3]); w.z = cvt_pk_bf16(v1[0], v1[1]); w.w = cvt_pk_bf16(v1[2], v1[3]);
                    *(u32x4*)(base + ai * s_ai + m * s_m + bj * s_bj) = w; }
    }
};
struct EpiDummy {
    static constexpr bool PERM = true;
    float* O;
    __device__ __forceinline__ void operator()(f32x4 (&acc)[2][2][4][2], const Unit& u, int wr, int wc, int fr, int fq) const {
        float s = 0.f;
#pragma unroll
        for (int ai = 0; ai < 2; ++ai)
#pragma unroll
            for (int bj = 0; bj < 2; ++bj)
#pragma unroll
                for (int m = 0; m < 4; ++m)
#pragma unroll
                    for (int n = 0; n < 2; ++n) s += (acc[ai][bj][m][n][0] + acc[ai][bj][m][n][1]) + (acc[ai][bj][m][n][2] + acc[ai][bj][m][n][3]);
        if (s == 12345.678f) O[u.pm * 256 + fr] = s;
    }
};
__device__ __forceinline__ float row_rstd(const float* ssq, int row, int fq) {
    const f32x4 a = *(const f32x4*)(ssq + (size_t)row * 32 + 8 * fq), b = *(const f32x4*)(ssq + (size_t)row * 32 + 8 * fq + 4);
    float t = ((a[0] + a[1]) + (a[2] + a[3])) + ((b[0] + b[1]) + (b[2] + b[3]));
    t += __shfl_xor(t, 16); t += __shfl_xor(t, 32);
    return rsqrtf(t * (1.0f / 2048.0f) + EPS);
}
template <bool RB>
struct EpiResid {
    static constexpr bool PERM = true;
    const void* res; bf16_t* outb; float* ssq;
    __device__ __forceinline__ void operator()(f32x4 (&acc)[2][2][4][2], const Unit& u, int wr, int wc, int fr, int fq) const {
        const int row0 = u.pm * BM + wr * 64 + fr, col0 = u.pn * BM + wc * 32 + 8 * fq;
#pragma unroll
        for (int ai = 0; ai < 2; ++ai) {
            f32x4 r[4][2][2];
#pragma unroll
            for (int m = 0; m < 4; ++m)
#pragma unroll
                for (int bj = 0; bj < 2; ++bj) { const size_t o = (size_t)(row0 + ai * HALF + m * 16) * DM + col0 + bj * HALF;
                    if (RB) { const u32x4 w = *(const u32x4*)((const bf16_t*)res + o); r[m][bj][0] = (f32x4){bflo(w.x), bfhi(w.x), bflo(w.y), bfhi(w.y)}; r[m][bj][1] = (f32x4){bflo(w.z), bfhi(w.z), bflo(w.w), bfhi(w.w)}; }
                    else { r[m][bj][0] = *(const f32x4*)((const float*)res + o); r[m][bj][1] = *(const f32x4*)((const float*)res + o + 4); } }
#pragma unroll
            for (int m = 0; m < 4; ++m) { const int row = row0 + ai * HALF + m * 16; const size_t off = (size_t)row * DM + col0; float s = 0.f;
#pragma unroll
                for (int bj = 0; bj < 2; ++bj) { const f32x4 v0 = acc[ai][bj][m][0] + r[m][bj][0], v1 = acc[ai][bj][m][1] + r[m][bj][1];
                    u32x4 w; w.x = cvt_pk_bf16(v0[0], v0[1]); w.y = cvt_pk_bf16(v0[2], v0[3]); w.z = cvt_pk_bf16(v1[0], v1[1]); w.w = cvt_pk_bf16(v1[2], v1[3]);
                    *(u32x4*)(outb + off + bj * HALF) = w;
                    s += ((v0[0] * v0[0] + v0[1] * v0[1]) + (v0[2] * v0[2] + v0[3] * v0[3])) + ((v1[0] * v1[0] + v1[1] * v1[1]) + (v1[2] * v1[2] + v1[3] * v1[3])); }
                s += __shfl_xor(s, 16); s += __shfl_xor(s, 32);
                if (fq == 0) ssq[(size_t)row * 32 + u.pn * 4 + wc] = s; }
            asm volatile("" ::: "memory"); }
    }
};
struct EpiPle {
    static constexpr bool PERM = true;
    const float* ssq_in; const bf16_t* pp; const bf16_t* hb; bf16_t* out; float* ssq;
    __device__ __forceinline__ void operator()(f32x4 (&acc)[2][2][4][2], const Unit& u, int wr, int wc, int fr, int fq) const {
        const int row0 = u.pm * BM + wr * 64 + fr, col0 = u.pn * BM + wc * 32 + 8 * fq;
        const bf16_t* ppf = pp + ((size_t)(u.pm * (DM / 256) + u.pn) << 16) + (size_t)((((wr * 4 + wc) * 16) * 64 + fq * 16 + fr) << 3);
#pragma unroll
        for (int ai = 0; ai < 2; ++ai) {
            u32x4 hw[4][2], pw[4][2]; float rstd[4];
#pragma unroll
            for (int m = 0; m < 4; ++m) { const int row = row0 + ai * HALF + m * 16;
#pragma unroll
                for (int bj = 0; bj < 2; ++bj) { const size_t o = (size_t)row * DM + col0 + bj * HALF; hw[m][bj] = *(const u32x4*)(hb + o); pw[m][bj] = *(const u32x4*)(ppf + (((ai * 4 + m) * 2 + bj) << 9)); }
                rstd[m] = row_rstd(ssq_in, row, fq); }
#pragma unroll
            for (int m = 0; m < 4; ++m) { const int row = row0 + ai * HALF + m * 16; const size_t off = (size_t)row * DM + col0; float s = 0.f;
#pragma unroll
                for (int bj = 0; bj < 2; ++bj) { const f32x4 z0 = acc[ai][bj][m][0] * rstd[m], z1 = acc[ai][bj][m][1] * rstd[m]; const u32x4 h2 = hw[m][bj], p2 = pw[m][bj]; f32x4 v0, v1;
                    v0[0] = bflo(h2.x) + sigmoidf_(z0[0]) * bflo(p2.x); v0[1] = bfhi(h2.x) + sigmoidf_(z0[1]) * bfhi(p2.x);
                    v0[2] = bflo(h2.y) + sigmoidf_(z0[2]) * bflo(p2.y); v0[3] = bfhi(h2.y) + sigmoidf_(z0[3]) * bfhi(p2.y);
                    v1[0] = bflo(h2.z) + sigmoidf_(z1[0]) * bflo(p2.z); v1[1] = bfhi(h2.z) + sigmoidf_(z1[1]) * bfhi(p2.z);
                    v1[2] = bflo(h2.w) + sigmoidf_(z1[2]) * bflo(p2.w); v1[3] = bfhi(h2.w) + sigmoidf_(z1[3]) * bfhi(p2.w);
                    u32x4 w; w.x = cvt_pk_bf16(v0[0], v0[1]); w.y = cvt_pk_bf16(v0[2], v0[3]); w.z = cvt_pk_bf16(v1[0], v1[1]); w.w = cvt_pk_bf16(v1[2], v1[3]);
                    *(u32x4*)(out + off + bj * HALF) = w;
                    s += ((v0[0] * v0[0] + v0[1] * v0[1]) + (v0[2] * v0[2] + v0[3] * v0[3])) + ((v1[0] * v1[0] + v1[1] * v1[1]) + (v1[2] * v1[2] + v1[3] * v1[3])); }
                s += __shfl_xor(s, 16); s += __shfl_xor(s, 32);
                if (fq == 0) ssq[(size_t)row * 32 + u.pn * 4 + wc] = s; }
            asm volatile("" ::: "memory"); }
    }
};
struct EpiConv {
    static constexpr bool PERM = false;
    const float* ssq_in; const float* cw; const float* cb; bf16_t* act; float* uedge; LAS float* ex; LAS float* cws; LAS float* rsl;
    __device__ __forceinline__ void conv_rows(const f32x4 curg, const f32x4 curv, f32x4 (&q1)[2], f32x4 (&q2)[2], const LAS float* cp, bf16_t* dst, const bool upd) const {
        f32x4 uc[2];
#pragma unroll
        for (int bj = 0; bj < 2; ++bj) {
            const f32x4 c0 = *(const LAS f32x4*)(cp + bj * 32), c1 = *(const LAS f32x4*)(cp + bj * 32 + 64), c2 = *(const LAS f32x4*)(cp + bj * 32 + 128), bb = *(const LAS f32x4*)(cp + bj * 32 + 192);
            const f32x4 cur = bj ? curv : curg;
#pragma unroll
            for (int e = 0; e < 4; ++e) {
                const float p1 = dpp_shr1(q1[bj][e], cur[e]), p2 = dpp_shr2(q2[bj][e], cur[e]);
                uc[bj][e] = bb[e] + c0[e] * p2 + c1[e] * p1 + c2[e] * cur[e];
                if (upd) { q1[bj][e] = dpp_ror1(cur[e]); q2[bj][e] = dpp_ror2(cur[e]); }
            }
        }
        u32x2 w;
        { const float a0 = uc[0][0] * sigmoidf_(uc[0][0]) * uc[1][0], a1 = uc[0][1] * sigmoidf_(uc[0][1]) * uc[1][1];
          const float a2 = uc[0][2] * sigmoidf_(uc[0][2]) * uc[1][2], a3 = uc[0][3] * sigmoidf_(uc[0][3]) * uc[1][3];
          w.x = cvt_pk_bf16(a0, a1); w.y = cvt_pk_bf16(a2, a3); }
        *(u32x2*)dst = w;
    }
    __device__ __forceinline__ void operator()(f32x4 (&acc)[2][2][4][2], const Unit& u, int wr, int wc, int fr, int fq) const {
        const int rowt = u.pm * BM + wr * 64 + fr, cl0 = wc * 32 + 4 * fq, wv = wr * 4 + wc, ln = fq * 16 + fr;
        float cwr[4];
#pragma unroll
        for (int i = 0; i < 4; ++i) { const float* srcp = (i < 3) ? (cw + (size_t)i * FF2) : cb; cwr[i] = srcp[(ln >> 5) * FF + u.pn * HALF + wc * 32 + (ln & 31)]; }
        {
            LAS float* myr = rsl + wv * 128; LAS int* mypm = (LAS int*)(rsl + 1024) + wv;
            if (__builtin_amdgcn_readfirstlane(*mypm) != u.pm) {
#pragma unroll
                for (int ai = 0; ai < 2; ++ai)
#pragma unroll
                    for (int m = 0; m < 4; ++m) { const float r_ = row_rstd(ssq_in, rowt + ai * HALF + m * 16, fq); if (fq == 0) myr[(ai * 4 + m) * 16 + fr] = r_; }
                if (fq == 0 && fr == 0) *mypm = u.pm;
                asm volatile("s_waitcnt lgkmcnt(0)" ::: "memory");
            }
#pragma unroll
            for (int ai = 0; ai < 2; ++ai)
#pragma unroll
                for (int m = 0; m < 4; ++m) { const float rstd = myr[(ai * 4 + m) * 16 + fr];
#pragma unroll
                    for (int bj = 0; bj < 2; ++bj)
#pragma unroll
                        for (int n = 0; n < 2; ++n) acc[ai][bj][m][n] *= rstd; }
        }
        if (fr >= 14) {
#pragma unroll
            for (int ai = 0; ai < 2; ++ai)
#pragma unroll
                for (int bj = 0; bj < 2; ++bj)
#pragma unroll
                    for (int n = 0; n < 2; ++n) *(LAS f32x4*)(ex + (((ai * 2 + wr) * 2 + (fr - 14)) * 256 + bj * HALF + cl0 + n * 16)) = acc[ai][bj][3][n];
        }
        if (wr == 0 && fr < 2) {
#pragma unroll
            for (int bj = 0; bj < 2; ++bj)
#pragma unroll
                for (int n = 0; n < 2; ++n) *(f32x4*)(uedge + ((size_t)(u.pm * 4 + fr) * FF2 + u.pn * BM + bj * HALF + cl0 + n * 16)) = acc[0][bj][0][n];
        }
        if (wr == 1 && fr >= 14) {
#pragma unroll
            for (int bj = 0; bj < 2; ++bj)
#pragma unroll
                for (int n = 0; n < 2; ++n) *(f32x4*)(uedge + ((size_t)(u.pm * 4 + 2 + (fr - 14)) * FF2 + u.pn * BM + bj * HALF + cl0 + n * 16)) = acc[1][bj][3][n];
        }
        LAS float* myc = cws + wv * 256;
#pragma unroll
        for (int i = 0; i < 4; ++i) myc[i * 64 + ln] = cwr[i];
        asm volatile("s_waitcnt lgkmcnt(0)" ::: "memory");
#pragma unroll
        for (int n = 0; n < 2; ++n) {
            const int jcol = u.pn * HALF + cl0 + n * 16; const LAS float* cp = myc + 16 * n + 4 * fq;
#pragma unroll
            for (int ai = 0; ai < 2; ++ai) {
                f32x4 q1[2], q2[2];
#pragma unroll
                for (int bj = 0; bj < 2; ++bj)
#pragma unroll
                    for (int e = 0; e < 4; ++e) { q1[bj][e] = dpp_ror1(acc[ai][bj][0][n][e]); q2[bj][e] = dpp_ror2(acc[ai][bj][0][n][e]); }
#pragma unroll
                for (int m = 1; m < 4; ++m) conv_rows(acc[ai][0][m][n], acc[ai][1][m][n], q1, q2, cp, act + (size_t)(rowt + ai * HALF + m * 16) * FF + jcol, m < 3);
            }
        }
        asm volatile("s_waitcnt lgkmcnt(0)" ::: "memory"); PG8_BAR; PG8_BAR; asm volatile("" ::: "memory");
#pragma unroll
        for (int n = 0; n < 2; ++n) {
            const int jcol = u.pn * HALF + cl0 + n * 16; const LAS float* cp = myc + 16 * n + 4 * fq;
#pragma unroll
            for (int ai = 0; ai < 2; ++ai) {
                const bool has_prev = !(ai == 0 && wr == 0);
                const int slot = (wr == 1) ? (ai * 2) : ((ai - 1) * 2 + 1);
                f32x4 q1[2], q2[2];
#pragma unroll
                for (int bj = 0; bj < 2; ++bj) {
                    f32x4 e0 = (f32x4){0.f, 0.f, 0.f, 0.f}, e1 = (f32x4){0.f, 0.f, 0.f, 0.f};
                    if (has_prev) { e0 = *(const LAS f32x4*)(ex + ((slot * 2 + 0) * 256 + bj * HALF + cl0 + n * 16)); e1 = *(const LAS f32x4*)(ex + ((slot * 2 + 1) * 256 + bj * HALF + cl0 + n * 16)); }
                    q1[bj] = e1;
#pragma unroll
                    for (int e = 0; e < 4; ++e) q2[bj][e] = (fr == 1) ? e1[e] : e0[e];
                }
                conv_rows(acc[ai][0][0][n], acc[ai][1][0][n], q1, q2, cp, act + (size_t)(rowt + ai * HALF) * FF + jcol, false);
            }
        }
    }
};
#undef PG8_BAR
}

__device__ void phase0(const Params& p, LAS unsigned char* lds, const int WID) {
    unsigned char* ws = p.ws;
    const int G = gridDim.x, bx = blockIdx.x, wid = WID, lane = lane_id_(), tid = wid * 64 + lane;
    { const float* x = p.in[0]; const float* gm = p.in[2]; bf16_t* xa = (bf16_t*)(ws + WS_XA);
      for (int r = bx * 8 + wid; r < MTOK; r += G * 8) { const float* xr = x + (size_t)r * DM; f32x4 v[8]; float s = 0.f;
#pragma unroll
          for (int i = 0; i < 8; ++i) { v[i] = __builtin_nontemporal_load((const f32x4*)(xr + i * 256 + lane * 4)); s += (v[i][0] * v[i][0] + v[i][1] * v[i][1]) + (v[i][2] * v[i][2] + v[i][3] * v[i][3]); }
#pragma unroll
          for (int o = 32; o >= 1; o >>= 1) s += __shfl_xor(s, o);
          const float rstd = rsqrtf(s * (1.0f / 2048.0f) + EPS);
#pragma unroll
          for (int i = 0; i < 8; ++i) { const f32x4 gv = *(const f32x4*)(gm + i * 256 + lane * 4); u32x2 w; w.x = cvt_pk_bf16(v[i][0] * rstd * gv[0], v[i][1] * rstd * gv[1]); w.y = cvt_pk_bf16(v[i][2] * rstd * gv[2], v[i][3] * rstd * gv[3]);
              *(u32x2*)(xa + (size_t)r * DM + i * 256 + lane * 4) = w; } } }
    { const float* pin = p.in[1]; bf16_t* pb = (bf16_t*)(ws + WS_PB);
      for (int i = bx * 512 + tid; i < MTOK * PLE / 4; i += G * 512) { const f32x4 v = __builtin_nontemporal_load((const f32x4*)(pin + (size_t)i * 4)); u32x2 w; w.x = cvt_pk_bf16(v[0], v[1]); w.y = cvt_pk_bf16(v[2], v[3]); *(u32x2*)(pb + (size_t)i * 4) = w; } }
    constexpr int J0 = 16 * 112, J1 = J0 + 16 * 32, J2 = J1 + 16 * 176, J3 = J2 + 44 * 32, J4 = J3 + 16 * 32, J5 = J4 + 2 * 32;
    const float* src = nullptr; bf16_t* dst = nullptr; const float* scale = nullptr; int K = 0, N = 0, mode = 0, k0 = 0, n0 = 0;
#define P0_DECODE(job) do { int tp_; \
        if ((job) < J0) { src = p.in[3]; dst = (bf16_t*)(ws + WS_WIN); scale = nullptr; K = DM; N = INC; mode = 0; tp_ = (job); } \
        else if ((job) < J1) { src = p.in[7]; dst = (bf16_t*)(ws + WS_WOUT); scale = nullptr; K = DM; N = DM; mode = 0; tp_ = (job) - J0; } \
        else if ((job) < J2) { src = p.in[9]; dst = (bf16_t*)(ws + WS_WUP); scale = p.in[8]; K = DM; N = FF2; mode = 1; tp_ = (job) - J1; } \
        else if ((job) < J3) { src = p.in[12]; dst = (bf16_t*)(ws + WS_WDOWN); scale = nullptr; K = FF; N = DM; mode = 0; tp_ = (job) - J2; } \
        else if ((job) < J4) { src = p.in[14]; dst = (bf16_t*)(ws + WS_WGATE); scale = p.in[13]; K = DM; N = DM; mode = 0; tp_ = (job) - J3; } \
        else { src = p.in[15]; dst = (bf16_t*)(ws + WS_WPROJ); scale = nullptr; K = PLE; N = DM; mode = 0; tp_ = (job) - J4; } \
        const int nk2_ = K >> 7; k0 = (tp_ % nk2_) * 128; n0 = (tp_ / nk2_) * 64; } while (0)
#define P0_LOAD() do { _Pragma("unroll") for (int i_ = 0; i_ < 4; ++i_) { const int kk_ = (tid >> 4) + 32 * i_; \
        v[i_] = __builtin_nontemporal_load((const f32x4*)(src + (size_t)(k0 + kk_) * N + n0 + (tid & 15) * 4)); sc[i_] = scale ? scale[k0 + kk_] : 1.0f; } } while (0)
    f32x4 v[4]; float sc[4];
    int job = bx, buf = 0;
    if (job < J5) { P0_DECODE(job); P0_LOAD(); }
    __syncthreads();
    while (job < J5) {
        LAS bf16_t* tl = (LAS bf16_t*)(lds + buf * 17408);
        const int nn = (tid & 15) * 4;
#pragma unroll
        for (int i = 0; i < 4; ++i) { const int kk = (tid >> 4) + 32 * i; const unsigned w0 = cvt_pk_bf16(v[i][0] * sc[i], v[i][1] * sc[i]), w1 = cvt_pk_bf16(v[i][2] * sc[i], v[i][3] * sc[i]);
            tl[(nn + 0) * 136 + kk] = (bf16_t)(w0 & 0xffff); tl[(nn + 1) * 136 + kk] = (bf16_t)(w0 >> 16); tl[(nn + 2) * 136 + kk] = (bf16_t)(w1 & 0xffff); tl[(nn + 3) * 136 + kk] = (bf16_t)(w1 >> 16); }
        bf16_t* cdst = dst; const int cK = K, cmode = mode, ck0 = k0, cn0 = n0; const bool late = job >= J0;
        const int nxt = job + G;
        if (nxt < J5) { P0_DECODE(nxt); P0_LOAD(); }
        __syncthreads();
        { const int n = tid >> 3, kc = (tid & 7) * 16; const LAS unsigned char* rp = lds + buf * 17408 + n * 272 + kc * 2;
          const u32x4 w0 = *(const LAS u32x4*)rp, w1 = *(const LAS u32x4*)(rp + 16);
          int R = cn0 + n;
          if (cmode == 1) { const int j = (R < FF) ? R : R - FF; R = 256 * (j >> 7) + (j & 127) + ((cn0 + n < FF) ? 0 : 128); }
          bf16_t* op = cdst + (size_t)R * cK + ck0 + kc;
          if (late) { __builtin_nontemporal_store(w0, (u32x4*)op); __builtin_nontemporal_store(w1, (u32x4*)(op + 8)); } else { *(u32x4*)op = w0; *(u32x4*)(op + 8) = w1; } }
        job = nxt; buf ^= 1;
    }
#undef P0_DECODE
#undef P0_LOAD
    __syncthreads();
}

__device__ __forceinline__ void attn_softmax(f32x4 (&sc)[4], float& m_run, float& l_run, f32x4 (&o)[8], const int j, const int tq, const int g, const LAS float* tb, bf16x8 (&pb)[2]) {
    const float SC = 0.08838834764831845f * LOG2E;
    float mx = m_run;
    if (j <= 5) { const float bc = tb[256];
#pragma unroll
        for (int mt = 0; mt < 4; ++mt)
#pragma unroll
            for (int e = 0; e < 4; ++e) { sc[mt][e] = sc[mt][e] * SC + bc; mx = fmaxf(mx, sc[mt][e]); } }
    else { const int relb = tq + 64 * (8 - j) - 4 * g;
#pragma unroll
        for (int mt = 0; mt < 4; ++mt)
#pragma unroll
            for (int e = 0; e < 4; ++e) { int rel = relb - 16 * mt - e; rel = rel > 128 ? 128 : rel; sc[mt][e] = sc[mt][e] * SC + tb[rel + 128]; mx = fmaxf(mx, sc[mt][e]); } }
    mx = fmaxf(mx, __shfl_xor(mx, 16)); mx = fmaxf(mx, __shfl_xor(mx, 32));
    const float alpha = __builtin_amdgcn_exp2f(m_run - mx); m_run = mx;
    float ls = 0.f;
#pragma unroll
    for (int mt = 0; mt < 4; ++mt)
#pragma unroll
        for (int e = 0; e < 4; ++e) { sc[mt][e] = __builtin_amdgcn_exp2f(sc[mt][e] - mx); ls += sc[mt][e]; }
    l_run = l_run * alpha + ls;
    if (__builtin_amdgcn_ballot_w64(alpha != 1.0f) != 0ull) {
#pragma unroll
        for (int cc = 0; cc < 8; ++cc) o[cc] *= alpha;
    }
#pragma unroll
    for (int s2 = 0; s2 < 2; ++s2) { u32x4 pw; pw.x = cvt_pk_bf16(sc[2 * s2][0], sc[2 * s2][1]); pw.y = cvt_pk_bf16(sc[2 * s2][2], sc[2 * s2][3]);
        pw.z = cvt_pk_bf16(sc[2 * s2 + 1][0], sc[2 * s2 + 1][1]); pw.w = cvt_pk_bf16(sc[2 * s2 + 1][2], sc[2 * s2 + 1][3]); pb[s2] = __builtin_bit_cast(bf16x8, pw); }
}
__device__ void attn_quad(const bf16_t* proj, const float* rel_bias, bf16_t* ycat, int quad, LAS unsigned char* lds, const int WID) {
    const int tid = TID_X, grp = WID >> 2, wq = WID & 3, lane = tid & 63, g = lane >> 4, li = lane & 15;
    const int bh = quad >> 4, c0 = (quad & 15) * 4, h = bh & 7, b = bh >> 3;
    const int kA = 2 * grp, kB = kA + 1;
    const int tokq = b * SEQ + c0 * 64;
    LAS float* tb = (LAS float*)(lds + 65536);
    __syncthreads();
    for (int i = tid; i < 257; i += 512) tb[i] = rel_bias[h * 257 + i] * LOG2E;
    bf16x8 qfA[4], qfB[4];
    { const int qr = tokq + kA * 64 + 16 * wq + li, qc = 4096 + 128 * h + 8 * g;
#pragma unroll
      for (int ks = 0; ks < 4; ++ks) { qfA[ks] = *(const bf16x8*)(proj + proj_off_fr(qr, qc + 32 * ks)); qfB[ks] = *(const bf16x8*)(proj + proj_off_fr(qr + 64, qc + 32 * ks)); } }
    float mA = -1e30f, lA = 0.f, mB = -1e30f, lB = 0.f; f32x4 oA[8], oB[8];
#pragma unroll
    for (int cc = 0; cc < 8; ++cc) { oA[cc] = (f32x4){0.f, 0.f, 0.f, 0.f}; oB[cc] = (f32x4){0.f, 0.f, 0.f, 0.f}; }
    const int u0 = (8 - c0) > 0 ? (8 - c0) : 0;
    const int srow = 16 * (WID & 3) + (tid & 15), sch = 4 * (WID >> 2) + ((tid >> 4) & 3);
    u32x4 kr0[2], vr0[2], kr1[2], vr1[2];
    const bf16_t* kb0 = proj + proj_off_fr(tokq - 512 + srow, 5120 + 128 * h + 8 * sch); const bf16_t* vb0 = proj + proj_off_fr(tokq - 512 + srow, 6144 + 128 * h + 8 * sch);
#define ATT_LOAD(u_, KR, VR) do { const long _o = (long)((u_) >> 2) * (28L << 16) + ((u_) & 1) * 32768 + (((u_) >> 1) & 1) * 4096; _Pragma("unroll") for (int _i = 0; _i < 2; ++_i) { \
        KR[_i] = *(const u32x4*)(kb0 + _o + _i * 16384); VR[_i] = *(const u32x4*)(vb0 + _o + _i * 16384); } } while (0)
#define ATT_STORE(buf_, KR, VR) do { _Pragma("unroll") for (int _i = 0; _i < 2; ++_i) { const unsigned ob_ = off_b(srow, sch + 8 * _i); \
        *(LAS u32x4*)(lds + (buf_) * 32768 + ob_) = KR[_i]; *(LAS u32x4*)(lds + (buf_) * 32768 + 16384 + ob_) = VR[_i]; } } while (0)
    const int tq = 16 * wq + li;
    const unsigned trq = (unsigned)(li >> 2), trp = (unsigned)(li & 3);
#define ATT_COMPUTE(u) do { \
        LAS unsigned char* Kimg = lds + buf * 32768; LAS unsigned char* Vimg = Kimg + 16384; \
        const bool actA = ((u) >= kA) && ((u) <= kA + 8), actB = ((u) >= kB) && ((u) <= kB + 8); \
        if (actA || actB) { \
            f32x4 sA[4], sB[4]; \
            _Pragma("unroll") for (int mt = 0; mt < 4; ++mt) { sA[mt] = (f32x4){0.f, 0.f, 0.f, 0.f}; sB[mt] = (f32x4){0.f, 0.f, 0.f, 0.f}; \
                _Pragma("unroll") for (int ks = 0; ks < 4; ++ks) { const bf16x8 a = *(const LAS bf16x8*)(Kimg + off_b(16 * mt + li, 4 * ks + g)); \
                    if (actA) sA[mt] = __builtin_amdgcn_mfma_f32_16x16x32_bf16(a, qfA[ks], sA[mt], 0, 0, 0); \
                    if (actB) sB[mt] = __builtin_amdgcn_mfma_f32_16x16x32_bf16(a, qfB[ks], sB[mt], 0, 0, 0); } } \
            bf16x8 pbA[2], pbB[2]; \
            pbA[0] = pbA[1] = pbB[0] = pbB[1] = (bf16x8){0, 0, 0, 0, 0, 0, 0, 0}; \
            if (actA) attn_softmax(sA, mA, lA, oA, (u) - kA, tq, g, tb, pbA); \
            if (actB) attn_softmax(sB, mB, lB, oB, (u) - kB, tq, g, tb, pbB); \
            _Pragma("unroll") for (int s2 = 0; s2 < 2; ++s2) { const unsigned r0 = 32 * s2 + 4 * g + trq, r1 = r0 + 16; \
                _Pragma("unroll") for (int cc = 0; cc < 8; ++cc) { \
                    const s16x4 lo = tr_read(Vimg + off_b(r0, 2 * cc + (trp >> 1)) + 8 * (trp & 1)), hi = tr_read(Vimg + off_b(r1, 2 * cc + (trp >> 1)) + 8 * (trp & 1)); \
                    const bf16x8 vf = cat8(lo, hi); \
                    if (actA) oA[cc] = __builtin_amdgcn_mfma_f32_16x16x32_bf16(vf, pbA[s2], oA[cc], 0, 0, 0); \
                    if (actB) oB[cc] = __builtin_amdgcn_mfma_f32_16x16x32_bf16(vf, pbB[s2], oB[cc], 0, 0, 0); \
                } } \
        } } while (0)
    ATT_LOAD(u0, kr0, vr0); ATT_LOAD(u0 + 1, kr1, vr1); ATT_STORE(0, kr0, vr0);
    __syncthreads();
    int buf = 0;
    for (int u = u0; u < 12; u += 2) {
        if (u + 2 < 12) ATT_LOAD(u + 2, kr0, vr0);
        ATT_COMPUTE(u);
        ATT_STORE(buf ^ 1, kr1, vr1);
        __syncthreads(); buf ^= 1;
        if (u + 3 < 12) ATT_LOAD(u + 3, kr1, vr1);
        ATT_COMPUTE(u + 1);
        if (u + 2 < 12) ATT_STORE(buf ^ 1, kr0, vr0);
        __syncthreads(); buf ^= 1;
    }
#undef ATT_COMPUTE
#undef ATT_LOAD
#undef ATT_STORE
    lA += __shfl_xor(lA, 16); lA += __shfl_xor(lA, 32); lB += __shfl_xor(lB, 16); lB += __shfl_xor(lB, 32);
    const float invA = 1.0f / lA, invB = 1.0f / lB;
    bf16_t* yp = ycat + (size_t)(tokq + kA * 64 + tq) * DM + 1024 + 128 * h + 4 * g;
#pragma unroll
    for (int cc = 0; cc < 8; ++cc) { u32x2 w; w.x = cvt_pk_bf16(oA[cc][0] * invA, oA[cc][1] * invA); w.y = cvt_pk_bf16(oA[cc][2] * invA, oA[cc][3] * invA); *(u32x2*)(yp + 16 * cc) = w;
        u32x2 w2; w2.x = cvt_pk_bf16(oB[cc][0] * invB, oB[cc][1] * invB); w2.y = cvt_pk_bf16(oB[cc][2] * invB, oB[cc][3] * invB); *(u32x2*)(yp + (size_t)64 * DM + 16 * cc) = w2; }
}

constexpr int HG_K = 0, HG_V = 16384, HG_Q1 = 32768, HG_Q2 = 49152, HG_S = 65536, HG_TOT = 98304, HG_RED = 102400;

__device__ void hgrn_state_loop(const bf16_t* proj, const float* lbl, float* ust, float* ddec, int task, const int stride, const int ntask, LAS unsigned char* lds, const int WID) {
    const int wid = WID, lane = lane_id_(), tid = wid * 64 + lane, g = lane >> 4, li = lane & 15;
    const int dp = tid & 63, sq = tid >> 6, d0 = 2 * dp;
    LAS float* tot = (LAS float*)(lds + HG_TOT);
    const unsigned trq = (unsigned)(li >> 2), trp = (unsigned)(li & 3);
    const int vrow = 16 * (wid & 3) + li, vch = 4 * (wid >> 2) + g;
    unsigned fw[8]; u32x4 vr[2]; float lbv[4];
#define H1_LOAD(task_) do { const int c_ = (task_) & 63, bh_ = (task_) >> 6, h_ = bh_ & 7, b_ = bh_ >> 3; const int tok_ = b_ * SEQ + c_ * 64; \
        lbv[0] = lbl[128 * h_ + d0]; lbv[1] = lbl[128 * h_ + d0 + 1]; lbv[2] = lbl[1024 + 128 * h_ + d0]; lbv[3] = lbl[1024 + 128 * h_ + d0 + 1]; \
        { const bf16_t* fb_ = proj + proj_off_rm(tok_ + 8 * sq, 1024 + 128 * h_ + d0); _Pragma("unroll") for (int i_ = 0; i_ < 8; ++i_) fw[i_] = *(const unsigned*)(fb_ + i_ * 256); } \
        { const bf16_t* vb_ = proj + proj_off_fr(tok_ + vrow, 2048 + 128 * h_ + 8 * vch); _Pragma("unroll") for (int i_ = 0; i_ < 2; ++i_) vr[i_] = *(const u32x4*)(vb_ + i_ * 16384); } } while (0)
    if (task < ntask) H1_LOAD(task);
    while (task < ntask) {
        const int c = task & 63, bh = task >> 6;
        const int ci = bh * 64 + c;
        __syncthreads();
        float lb[2];
        lb[0] = __builtin_amdgcn_rcpf(1.0f + __expf(lbv[2] - lbv[0])); lb[1] = __builtin_amdgcn_rcpf(1.0f + __expf(lbv[3] - lbv[1]));
        float cs[8][2], kg[8][2];
        { float run0 = 0.f, run1 = 0.f;
#pragma unroll
          for (int i = 0; i < 8; ++i) { const unsigned w = fw[i];
              const float s0 = sigmoidf_(bflo(w)), s1 = sigmoidf_(bfhi(w));
              run0 += __logf(lb[0] + (1.0f - lb[0]) * s0); run1 += __logf(lb[1] + (1.0f - lb[1]) * s1);
              cs[i][0] = run0; cs[i][1] = run1; kg[i][0] = (1.0f - lb[0]) * (1.0f - s0); kg[i][1] = (1.0f - lb[1]) * (1.0f - s1); }
          tot[sq * 128 + d0] = run0; tot[sq * 128 + d0 + 1] = run1; }
#pragma unroll
        for (int i = 0; i < 2; ++i) *(LAS u32x4*)(lds + HG_V + off_b(vrow, vch + 8 * i)) = vr[i];
        const int nxt = task + stride;
        if (nxt < ntask) H1_LOAD(nxt);
        __syncthreads();
        float pre0 = 0.f, pre1 = 0.f, bl0 = 0.f, bl1 = 0.f;
#pragma unroll
        for (int q = 0; q < 8; ++q) { const float t0 = tot[q * 128 + d0], t1 = tot[q * 128 + d0 + 1]; if (q < sq) { pre0 += t0; pre1 += t1; } bl0 += t0; bl1 += t1; }
#pragma unroll
        for (int i = 0; i < 8; ++i) { const int s_ = 8 * sq + i; const float k0 = kg[i][0] * __expf(bl0 - (pre0 + cs[i][0])), k1 = kg[i][1] * __expf(bl1 - (pre1 + cs[i][1]));
            *(LAS unsigned*)(lds + HG_K + off_b(s_, dp >> 2) + (dp & 3) * 4) = cvt_pk_bf16(k0, k1); }
        if (sq == 0) { f32x2 dv; dv.x = __expf(bl0); dv.y = __expf(bl1); *(f32x2*)(ddec + (size_t)ci * 128 + d0) = dv; }
        __syncthreads();
        f32x4 acc[8];
#pragma unroll
        for (int nt = 0; nt < 8; ++nt) acc[nt] = (f32x4){0.f, 0.f, 0.f, 0.f};
#pragma unroll
        for (int ks = 0; ks < 2; ++ks) {
            const unsigned r0 = 32 * ks + 8 * g + trq, r1 = r0 + 4;
            const bf16x8 a = cat8(tr_read(lds + HG_K + off_b(r0, 2 * wid + (trp >> 1)) + 8 * (trp & 1)), tr_read(lds + HG_K + off_b(r1, 2 * wid + (trp >> 1)) + 8 * (trp & 1)));
#pragma unroll
            for (int nt = 0; nt < 8; ++nt) {
                const bf16x8 bb = cat8(tr_read(lds + HG_V + off_b(r0, 2 * nt + (trp >> 1)) + 8 * (trp & 1)), tr_read(lds + HG_V + off_b(r1, 2 * nt + (trp >> 1)) + 8 * (trp & 1)));
                acc[nt] = __builtin_amdgcn_mfma_f32_16x16x32_bf16(a, bb, acc[nt], 0, 0, 0);
            }
        }
        bf16_t* up = (bf16_t*)ust + (size_t)ci * 16384 + 16 * wid + 4 * g;
#pragma unroll
        for (int nt = 0; nt < 8; ++nt) { u32x2 w; w.x = cvt_pk_bf16(acc[nt][0], acc[nt][1]); w.y = cvt_pk_bf16(acc[nt][2], acc[nt][3]); *(u32x2*)(up + (size_t)(16 * nt + li) * 128) = w; }
        task = nxt;
    }
#undef H1_LOAD
}

__device__ void hgrn_scan(const float* ust, const float* ddec, bf16_t* sst, const int WID) {
    for (int e4 = blockIdx.x * 512 + TID_X; e4 < 32 * 4096; e4 += gridDim.x * 512) {
        const int bh = e4 >> 12, off = (e4 & 4095) * 4, d = off & 127;
        f32x4 S = (f32x4){0.f, 0.f, 0.f, 0.f};
        const bf16_t* up = (const bf16_t*)ust + (size_t)bh * 64 * 16384 + off; const float* dp = ddec + (size_t)bh * 64 * 128 + d; bf16_t* sp = sst + (size_t)bh * 64 * 16384 + off;
#pragma unroll 16
        for (int c = 0; c < 64; ++c) {
            const u32x2 uw = *(const u32x2*)(up + (size_t)c * 16384); const f32x4 U = (f32x4){bflo(uw.x), bfhi(uw.x), bflo(uw.y), bfhi(uw.y)}; const f32x4 Dv = *(const f32x4*)(dp + c * 128);
            u32x2 w; w.x = cvt_pk_bf16(S[0], S[1]); w.y = cvt_pk_bf16(S[2], S[3]); *(u32x2*)(sp + (size_t)c * 16384) = w;
            S = Dv * S + U;
        }
    }
}

__device__ void hgrn_out_loop(const bf16_t* proj, const float* lbl, const bf16_t* sst, const float* hgn, bf16_t* ycat, int task, const int stride, const int ntask, LAS unsigned char* lds, const int WID) {
    const int wid = WID, lane = lane_id_(), tid = wid * 64 + lane, g = lane >> 4, li = lane & 15;
    const int dp = tid & 63, sq = tid >> 6, d0 = 2 * dp;
    const int nt = wid & 3, vh = wid >> 2, tloc = 16 * nt + li;
    LAS float* tot = (LAS float*)(lds + HG_TOT);
    LAS float* red = (LAS float*)(lds + HG_RED);
    const unsigned trq = (unsigned)(li >> 2), trp = (unsigned)(li & 3);
    const int vrow = 16 * (wid & 3) + li, vch = 4 * (wid >> 2) + g;
    f32x4 nv[4];
#pragma unroll
    for (int vt = 0; vt < 4; ++vt) nv[vt] = *(const f32x4*)(hgn + 16 * (4 * vh + vt) + 4 * g);
    unsigned fw[8], qw[8]; u32x4 vr[2], sr[4]; u32x2 gw[4], gwn[4]; float lbv[4];
#define H3_LOAD(task_, GW) do { const int c_ = (task_) & 63, bh_ = (task_) >> 6, h_ = bh_ & 7, b_ = bh_ >> 3; const int tok_ = b_ * SEQ + c_ * 64; const size_t ci_ = (size_t)(bh_ * 64 + c_); \
        lbv[0] = lbl[128 * h_ + d0]; lbv[1] = lbl[128 * h_ + d0 + 1]; lbv[2] = lbl[1024 + 128 * h_ + d0]; lbv[3] = lbl[1024 + 128 * h_ + d0 + 1]; \
        { const bf16_t* qb_ = proj + proj_off_rm(tok_ + 8 * sq, 128 * h_ + d0); _Pragma("unroll") for (int i_ = 0; i_ < 8; ++i_) { fw[i_] = *(const unsigned*)(qb_ + (4L << 16) + i_ * 256); qw[i_] = *(const unsigned*)(qb_ + i_ * 256); } } \
        { const bf16_t* vb_ = proj + proj_off_fr(tok_ + vrow, 2048 + 128 * h_ + 8 * vch); _Pragma("unroll") for (int i_ = 0; i_ < 2; ++i_) vr[i_] = *(const u32x4*)(vb_ + i_ * 16384); } \
        _Pragma("unroll") for (int i_ = 0; i_ < 4; ++i_) { const int n_ = tid + 512 * i_; sr[i_] = *(const u32x4*)(sst + ci_ * 16384 + (n_ >> 4) * 128 + 8 * (n_ & 15)); } \
        { const bf16_t* gb_ = proj + proj_off_fr(tok_ + tloc, 3072 + 128 * h_ + 4 * g + 64 * vh); _Pragma("unroll") for (int vt_ = 0; vt_ < 4; ++vt_) GW[vt_] = *(const u32x2*)(gb_ + (vt_ & 1) * 256 + (vt_ >> 1) * 8192); } } while (0)
    if (task < ntask) H3_LOAD(task, gw);
    while (task < ntask) {
        const int c = task & 63, bh = task >> 6, h = bh & 7, b = bh >> 3;
        const int tok0 = b * SEQ + c * 64;
        __syncthreads();
        float lb[2];
        lb[0] = __builtin_amdgcn_rcpf(1.0f + __expf(lbv[2] - lbv[0])); lb[1] = __builtin_amdgcn_rcpf(1.0f + __expf(lbv[3] - lbv[1]));
        float cs[8][2], kg[8][2], qs[8][2];
        { float run0 = 0.f, run1 = 0.f;
#pragma unroll
          for (int i = 0; i < 8; ++i) { const unsigned w = fw[i], wq_ = qw[i];
              const float s0 = sigmoidf_(bflo(w)), s1 = sigmoidf_(bfhi(w));
              run0 += __logf(lb[0] + (1.0f - lb[0]) * s0); run1 += __logf(lb[1] + (1.0f - lb[1]) * s1);
              cs[i][0] = run0; cs[i][1] = run1; kg[i][0] = (1.0f - lb[0]) * (1.0f - s0); kg[i][1] = (1.0f - lb[1]) * (1.0f - s1);
              const float q0 = bflo(wq_), q1 = bfhi(wq_); qs[i][0] = q0 * sigmoidf_(q0); qs[i][1] = q1 * sigmoidf_(q1); }
          tot[sq * 128 + d0] = run0; tot[sq * 128 + d0 + 1] = run1; }
#pragma unroll
        for (int i = 0; i < 2; ++i) *(LAS u32x4*)(lds + HG_V + off_b(vrow, vch + 8 * i)) = vr[i];
#pragma unroll
        for (int i = 0; i < 4; ++i) { const int n = tid + 512 * i; *(LAS u32x4*)(lds + HG_S + off_b(n >> 4, n & 15)) = sr[i]; }
        __syncthreads();
        { float pre0 = 0.f, pre1 = 0.f, bm0 = 0.f, bm1 = 0.f;
#pragma unroll
          for (int q = 0; q < 8; ++q) { const float t0 = tot[q * 128 + d0], t1 = tot[q * 128 + d0 + 1]; if (q < sq) { pre0 += t0; pre1 += t1; } if (q < 4) { bm0 += t0; bm1 += t1; } }
#pragma unroll
          for (int i = 0; i < 8; ++i) { const int s_ = 8 * sq + i; const float b0 = pre0 + cs[i][0], b1 = pre1 + cs[i][1];
              const unsigned o_ = off_b(s_, dp >> 2) + (dp & 3) * 4;
              *(LAS unsigned*)(lds + HG_K + o_) = cvt_pk_bf16(kg[i][0] * __expf(bm0 - b0), kg[i][1] * __expf(bm1 - b1));
              *(LAS unsigned*)(lds + HG_Q1 + o_) = cvt_pk_bf16(qs[i][0] * __expf(b0 - bm0), qs[i][1] * __expf(b1 - bm1));
              *(LAS unsigned*)(lds + HG_Q2 + o_) = cvt_pk_bf16(qs[i][0] * __expf(b0), qs[i][1] * __expf(b1)); } }
        const int nxt = task + stride;
        if (nxt < ntask) H3_LOAD(nxt, gwn);
        __syncthreads();
        bf16x8 q1f[4], q2f[4];
#pragma unroll
        for (int ks = 0; ks < 4; ++ks) { q1f[ks] = *(const LAS bf16x8*)(lds + HG_Q1 + off_b(16 * nt + li, 4 * ks + g)); q2f[ks] = *(const LAS bf16x8*)(lds + HG_Q2 + off_b(16 * nt + li, 4 * ks + g)); }
        f32x4 sc[4];
#pragma unroll
        for (int mt = 0; mt < 4; ++mt) { sc[mt] = (f32x4){0.f, 0.f, 0.f, 0.f};
            if (mt <= nt) {
#pragma unroll
                for (int ks = 0; ks < 4; ++ks) { const bf16x8 a = *(const LAS bf16x8*)(lds + HG_K + off_b(16 * mt + li, 4 * ks + g)); sc[mt] = __builtin_amdgcn_mfma_f32_16x16x32_bf16(a, q1f[ks], sc[mt], 0, 0, 0); }
#pragma unroll
                for (int e = 0; e < 4; ++e) { const int s_ = 16 * mt + 4 * g + e; sc[mt][e] = (s_ <= tloc) ? sc[mt][e] : 0.f; }
            } }
        bf16x8 pb[2];
#pragma unroll
        for (int s2 = 0; s2 < 2; ++s2) { u32x4 pw; pw.x = cvt_pk_bf16(sc[2 * s2][0], sc[2 * s2][1]); pw.y = cvt_pk_bf16(sc[2 * s2][2], sc[2 * s2][3]);
            pw.z = cvt_pk_bf16(sc[2 * s2 + 1][0], sc[2 * s2 + 1][1]); pw.w = cvt_pk_bf16(sc[2 * s2 + 1][2], sc[2 * s2 + 1][3]); pb[s2] = __builtin_bit_cast(bf16x8, pw); }
        f32x4 o[4];
#pragma unroll
        for (int vt = 0; vt < 4; ++vt) { o[vt] = (f32x4){0.f, 0.f, 0.f, 0.f}; const int vtile = 4 * vh + vt;
#pragma unroll
            for (int ks = 0; ks < 4; ++ks) { const bf16x8 a = *(const LAS bf16x8*)(lds + HG_S + off_b(16 * vtile + li, 4 * ks + g)); o[vt] = __builtin_amdgcn_mfma_f32_16x16x32_bf16(a, q2f[ks], o[vt], 0, 0, 0); }
#pragma unroll
            for (int s2 = 0; s2 < 2; ++s2) { const unsigned r0 = 32 * s2 + 4 * g + trq, r1 = r0 + 16;
                const bf16x8 a = cat8(tr_read(lds + HG_V + off_b(r0, 2 * vtile + (trp >> 1)) + 8 * (trp & 1)), tr_read(lds + HG_V + off_b(r1, 2 * vtile + (trp >> 1)) + 8 * (trp & 1)));
                o[vt] = __builtin_amdgcn_mfma_f32_16x16x32_bf16(a, pb[s2], o[vt], 0, 0, 0); }
        }
        float ss = 0.f;
#pragma unroll
        for (int vt = 0; vt < 4; ++vt) ss += (o[vt][0] * o[vt][0] + o[vt][1] * o[vt][1]) + (o[vt][2] * o[vt][2] + o[vt][3] * o[vt][3]);
        ss += __shfl_xor(ss, 16); ss += __shfl_xor(ss, 32);
        if (g == 0) red[wid * 16 + li] = ss;
        __syncthreads();
        const float tot2 = red[wid * 16 + li] + red[(wid ^ 4) * 16 + li];
        const float rstd = rsqrtf(tot2 * (1.0f / 128.0f) + EPS);
        bf16_t* yp = ycat + (size_t)(tok0 + tloc) * DM + 128 * h + 4 * g;
#pragma unroll
        for (int vt = 0; vt < 4; ++vt) { const int v0 = 16 * (4 * vh + vt); const u32x2 gwv = gw[vt];
            const float g0 = bflo(gwv.x), g1 = bfhi(gwv.x), g2 = bflo(gwv.y), g3 = bfhi(gwv.y);
            u32x2 w; w.x = cvt_pk_bf16(o[vt][0] * rstd * nv[vt][0] * g0 * sigmoidf_(g0), o[vt][1] * rstd * nv[vt][1] * g1 * sigmoidf_(g1));
            w.y = cvt_pk_bf16(o[vt][2] * rstd * nv[vt][2] * g2 * sigmoidf_(g2), o[vt][3] * rstd * nv[vt][3] * g3 * sigmoidf_(g3));
            *(u32x2*)(yp + v0) = w; }
#pragma unroll
        for (int vt = 0; vt < 4; ++vt) gw[vt] = gwn[vt];
        task = nxt;
    }
#undef H3_LOAD
}

__device__ void conv_fixup(const float* uedge, const float* cw, const float* cb, bf16_t* act, int pm, const int WID) {
    const bool hp = (pm & 15) != 0;
    const float* e = uedge + (size_t)pm * 4 * FF2; const float* ep = uedge + (size_t)(pm - 1) * 4 * FF2;
    for (int idx = TID_X; idx < 2 * FF; idx += 512) {
        const int r = idx / FF, j = idx - r * FF; const int cg_ = 256 * (j >> 7) + (j & 127);
        float uc[2];
#pragma unroll
        for (int bj = 0; bj < 2; ++bj) { const int cc = cg_ + 128 * bj, no = j + FF * bj;
            const float u0 = e[cc], u1 = e[FF2 + cc];
            const float p254 = hp ? ep[2 * FF2 + cc] : 0.f, p255 = hp ? ep[3 * FF2 + cc] : 0.f;
            const float c0 = cw[no], c1 = cw[FF2 + no], c2 = cw[2 * FF2 + no], bb = cb[no];
            uc[bj] = (r == 0) ? (bb + c2 * u0 + c1 * p255 + c0 * p254) : (bb + c2 * u1 + c1 * u0 + c0 * p255); }
        const float a = uc[0] * sigmoidf_(uc[0]) * uc[1];
        act[(size_t)(pm * 256 + r) * FF + j] = (bf16_t)(cvt_pk_bf16(a, 0.f) & 0xffff);
    }
}

#ifndef REP_P0
#define REP_P0 1
#endif
#ifndef REP_ATT
#define REP_ATT 1
#endif
#ifndef REP_H1
#define REP_H1 1
#endif
#ifndef REP_H2
#define REP_H2 1
#endif
#ifndef REP_H3
#define REP_H3 1
#endif
#ifndef REP_G1
#define REP_G1 1
#endif
#ifndef REP_G2
#define REP_G2 1
#endif
#ifndef REP_GPP
#define REP_GPP 1
#endif
#ifndef REP_G3
#define REP_G3 1
#endif
#ifndef REP_DUMMY
#define REP_DUMMY 0
#endif
#ifndef REP_SYNC
#define REP_SYNC 1
#endif
#define GSYNC() do { for (int s_ = 0; s_ < REP_SYNC; ++s_) xcd_barrier(xb, WID); } while (0)
__global__ void __launch_bounds__(512) mega(Params p) {
    extern __shared__ __attribute__((aligned(16))) unsigned char lds_raw[];
    LAS unsigned char* lds = (LAS unsigned char*)lds_raw;
    cg::grid_group grid = cg::this_grid();
    unsigned char* ws = p.ws;
    const int G = gridDim.x, bx = blockIdx.x;
    const int WID = __builtin_amdgcn_readfirstlane(threadIdx.x >> 6);
    volatile LAS unsigned* stw = (volatile LAS unsigned*)(lds + LDS_BYTES - 16);
    XcdBarrier xb; xb.bar = (unsigned*)(ws + WS_BAR); xb.x = xb_xcc_id(); xb.st = stw;
    if (threadIdx.x == 0) { stw[0] = 0u; stw[1] = 0u; stw[2] = xb_add(&xb.bar[XB_XCNT(xb.x)], 1u); stw[3] = 0u; }
    bf16_t* proj = (bf16_t*)(ws + WS_PROJ); bf16_t* ycat = (bf16_t*)(ws + WS_YCAT);

    for (int r_ = 0; r_ < REP_P0; ++r_) phase0(p, lds, WID);
    grid.sync();
    if (WID == 0 && lane_id_() == 0) { bool uni = (G == 256);
        for (int j = 0; j < 16; ++j) { const unsigned cnt = xb_ld(&xb.bar[XB_XCNT(j)]); uni = uni && (cnt == (j < 8 ? 32u : 0u)); }
        stw[3] = uni ? 1u : 0u; }
    __syncthreads();
    const bool uni_ = __builtin_amdgcn_readfirstlane((int)stw[3]) != 0; const int rank_ = __builtin_amdgcn_readfirstlane((int)stw[2]);
    const int cg_ = uni_ ? (rank_ * 8 + (int)xb.x) : bx, cl_ = uni_ ? ((int)xb.x * 32 + rank_) : bx;
    { pg8::Gemm g{(const bf16_t*)(ws + WS_XA), (const bf16_t*)(ws + WS_WIN), MTOK, INC, DM}; pg8::StaticOrder S; S.init(MTOK, INC, G, cg_);
      pg8::EpiPlainBf16 E{proj, INC, INC / 256}; for (int r_ = 0; r_ < REP_G1; ++r_) pg8::gemm_phase(WID, lds, g, S, E);
      pg8::EpiDummy ED{p.out}; for (int r_ = 0; r_ < REP_DUMMY; ++r_) pg8::gemm_phase<pg8::EpiDummy, true>(WID, lds, g, S, ED); }
    GSYNC();
    for (int r_ = 0; r_ < REP_H1; ++r_)
    hgrn_state_loop(proj, p.in[4], p.out, (float*)(ws + WS_DDEC), cl_, G, 2048, lds, WID);
    GSYNC();
    for (int st = 0; st < 2; ++st) {
        if ((st == 0) == ((cl_ & 1) == 0)) {
            for (int r_ = 0; r_ < REP_ATT; ++r_)
            for (int q = cl_; q < 512; q += G) attn_quad(proj, p.in[6], ycat, q, lds, WID);
        } else {
            for (int r_ = 0; r_ < REP_H2; ++r_)
            hgrn_scan(p.out, (const float*)(ws + WS_DDEC), (bf16_t*)(ws + WS_SST), WID);
        }
    }
    GSYNC();
    for (int r_ = 0; r_ < REP_H3; ++r_)
    hgrn_out_loop(proj, p.in[4], (const bf16_t*)(ws + WS_SST), p.in[5], ycat, cl_, G, 2048, lds, WID);
    GSYNC();
    { pg8::Gemm g{ycat, (const bf16_t*)(ws + WS_WOUT), MTOK, DM, DM}; pg8::StaticOrder S; S.init(MTOK, DM, G, cg_);
      pg8::EpiResid<false> E{p.in[0], (bf16_t*)(ws + WS_H1B), (float*)(ws + WS_SSQ1)}; for (int r_ = 0; r_ < REP_G2; ++r_) pg8::gemm_phase(WID, lds, g, S, E); }
    { pg8::Gemm g{(const bf16_t*)(ws + WS_PB), (const bf16_t*)(ws + WS_WPROJ), MTOK, DM, PLE}; pg8::StaticOrder S; S.init(MTOK, DM, G, cg_);
      pg8::EpiPlainBf16 E{(bf16_t*)(ws + WS_PP), DM, DM / 256, 0};     for (int r_ = 0; r_ < REP_GPP; ++r_) pg8::gemm_phase(WID, lds, g, S, E); }
    GSYNC();
    { pg8::Gemm g{(const bf16_t*)(ws + WS_H1B), (const bf16_t*)(ws + WS_WUP), MTOK, FF2, DM}; pg8::StaticOrder S; S.init(MTOK, FF2, G, cg_);
      pg8::EpiConv E{(const float*)(ws + WS_SSQ1), p.in[10], p.in[11], (bf16_t*)(ws + WS_ACT), (float*)(ws + WS_UEDGE), (LAS float*)(lds + pg8::STAGE_BYTES), (LAS float*)(lds + pg8::STAGE_BYTES + 8192), (LAS float*)(lds + pg8::STAGE_BYTES + 16384)};
      if (lane_id_() == 0) ((LAS int*)(lds + pg8::STAGE_BYTES + 16384 + 4096))[WID] = -1;
      __syncthreads();
      for (int r_ = 0; r_ < REP_G3; ++r_) pg8::gemm_phase(WID, lds, g, S, E); }
    GSYNC();
    { pg8::StaticOrder S; S.init(MTOK, DM, G, cg_); pg8::Unit u; int last = -1;
      for (int i = 0; S.next(i, u); ++i) if (u.pm != last) { conv_fixup((const float*)(ws + WS_UEDGE), p.in[10], p.in[11], (bf16_t*)(ws + WS_ACT), u.pm, WID); last = u.pm; }
      __threadfence(); __syncthreads();
      pg8::Gemm g{(const bf16_t*)(ws + WS_ACT), (const bf16_t*)(ws + WS_WDOWN), MTOK, DM, FF};
      pg8::EpiResid<true> E{(const void*)(ws + WS_H1B), (bf16_t*)(ws + WS_H1B), (float*)(ws + WS_SSQ2)}; pg8::gemm_phase(WID, lds, g, S, E); }
    GSYNC();
    { pg8::Gemm g{(const bf16_t*)(ws + WS_H1B), (const bf16_t*)(ws + WS_WGATE), MTOK, DM, DM}; pg8::StaticOrder S; S.init(MTOK, DM, G, cg_);
      pg8::EpiPle E{(const float*)(ws + WS_SSQ2), (const bf16_t*)(ws + WS_PP), (const bf16_t*)(ws + WS_H1B), (bf16_t*)(ws + WS_ACT), (float*)(ws + WS_SSQ3)}; pg8::gemm_phase(WID, lds, g, S, E); }
    GSYNC();
    { const int wid = WID, lane = lane_id_(); const float* fn = p.in[16]; const float* ssq = (const float*)(ws + WS_SSQ3); const bf16_t* h3b = (const bf16_t*)(ws + WS_ACT);
      for (int r = bx * 8 + wid; r < MTOK; r += G * 8) { float* xr = p.out + (size_t)r * DM; const bf16_t* hr = h3b + (size_t)r * DM;
          u32x4 hv[4];
#pragma unroll
          for (int i = 0; i < 4; ++i) hv[i] = *(const u32x4*)(hr + i * 512 + lane * 8);
          float s = (lane < 32) ? ssq[(size_t)r * 32 + lane] : 0.f;
#pragma unroll
          for (int o = 32; o >= 1; o >>= 1) s += __shfl_xor(s, o);
          const float rstd = rsqrtf(s * (1.0f / 2048.0f) + EPS);
#pragma unroll
          for (int i = 0; i < 4; ++i) { const f32x4 g0 = *(const f32x4*)(fn + i * 512 + lane * 8), g1 = *(const f32x4*)(fn + i * 512 + lane * 8 + 4);
              f32x4 a, b2; a[0] = bflo(hv[i].x) * rstd * g0[0]; a[1] = bfhi(hv[i].x) * rstd * g0[1]; a[2] = bflo(hv[i].y) * rstd * g0[2]; a[3] = bfhi(hv[i].y) * rstd * g0[3];
              b2[0] = bflo(hv[i].z) * rstd * g1[0]; b2[1] = bfhi(hv[i].z) * rstd * g1[1]; b2[2] = bflo(hv[i].w) * rstd * g1[2]; b2[3] = bfhi(hv[i].w) * rstd * g1[3];
              __builtin_nontemporal_store(a, (f32x4*)(xr + i * 512 + lane * 8)); __builtin_nontemporal_store(b2, (f32x4*)(xr + i * 512 + lane * 8 + 4)); } } }
}

extern "C" void kernel_launch(void* const* d_in, const int* in_sizes, int n_in, void* d_out, int out_size, void* d_ws, size_t ws_size, hipStream_t stream) {
    static int grid = 0;
    if (grid == 0) {
        if (n_in != 17 || out_size != MTOK * DM || ws_size < WS_END) { fprintf(stderr, "kernel_launch: unexpected shapes (n_in %d out %d ws %zu)\n", n_in, out_size, ws_size); grid = -1; return; }
        int dev = 0, cus = 0, per_cu = 0;
        (void)hipGetDevice(&dev);
        (void)hipDeviceGetAttribute(&cus, hipDeviceAttributeMultiprocessorCount, dev);
        if (hipFuncSetAttribute((const void*)mega, hipFuncAttributeMaxDynamicSharedMemorySize, LDS_BYTES) != hipSuccess) { fprintf(stderr, "hipFuncSetAttribute failed\n"); grid = -1; return; }
        if (hipOccupancyMaxActiveBlocksPerMultiprocessor(&per_cu, (const void*)mega, 512, LDS_BYTES) != hipSuccess || per_cu < 1) { fprintf(stderr, "occupancy query: %d\n", per_cu); (void)hipGetLastError(); grid = -1; return; }
        grid = cus;
    }
    if (grid < 0) return;
    Params p{};
    for (int i = 0; i < 17; ++i) p.in[i] = (const float*)d_in[i];
    p.out = (float*)d_out; p.ws = (unsigned char*)d_ws;
    void* args[] = {&p};
    if (hipMemsetAsync((unsigned char*)d_ws + WS_BAR, 0, XCD_BAR_WORDS * 4, stream) != hipSuccess) { fprintf(stderr, "memset failed\n"); return; }
    hipError_t e = hipLaunchCooperativeKernel((const void*)mega, dim3(grid), dim3(512), args, LDS_BYTES, stream);
    if (e != hipSuccess) fprintf(stderr, "cooperative launch failed: %s\n", hipGetErrorString(e));
}
```
